# Optimizing an MI355X kernel written in HIP

```python
import jax, jax.numpy as jnp
from jax import lax
import numpy as np

D_MODEL = 2048
BATCH = 4
SEQ = 2048
DEPTH = 1
DEC_BATCH = 128
DEC_SEQ = 1
PAST_LEN = 16384
PAGE_SIZE = 128

POOL_WIDTH = D_MODEL // 2
POOL_GROUPS = 4
POOL_GROUP_DIM = POOL_WIDTH // POOL_GROUPS
POOL_WINDOWS = (2, 4, 8, 16)
POOL_STATE = max(POOL_WINDOWS) - 1
CONV_WIDTH = D_MODEL // 2
CONV_K = 3
CONV_STATE = CONV_K - 1
D_FF = ((8 * D_MODEL // 3 + 255) // 256) * 256
N_MOD = 9
IN_COLS = POOL_WIDTH + 3 * CONV_WIDTH + 2 * D_MODEL
EPS = 1e-6

kernel_name = "cond_macaron_pool_shortconv_decoder_step"


def rmsnorm(x, g):
    xf = x.astype(jnp.float32)
    inv = lax.rsqrt(jnp.mean(xf * xf, axis=-1, keepdims=True) + EPS)
    return (xf * inv).astype(x.dtype) * g


def modulate(x, g, shift, scale):
    return rmsnorm(x, g) * (1.0 + scale[:, None, :]) + shift[:, None, :]


def swiglu(h, w_gate, w_up, w_down):
    return (jax.nn.silu(h @ w_gate) * (h @ w_up)) @ w_down


def multiscale_pool(buf, n_new, pos0):
    L = buf.shape[1]
    start = L - n_new
    cs = jnp.cumsum(buf.astype(jnp.float32), axis=1)
    cs = jnp.concatenate([jnp.zeros_like(cs[:, :1]), cs], axis=1)
    idx = start + jnp.arange(n_new)
    pos = pos0 + jnp.arange(n_new)
    hi = cs[:, idx + 1]
    outs = []
    for g, w in enumerate(POOL_WINDOWS):
        sl = slice(g * POOL_GROUP_DIM, (g + 1) * POOL_GROUP_DIM)
        lo = cs[:, jnp.maximum(idx + 1 - w, 0), sl]
        cnt = jnp.minimum(pos + 1, w).astype(jnp.float32)[None, :, None]
        outs.append((hi[..., sl] - lo) / cnt)
    pooled = jnp.concatenate(outs, axis=-1).astype(buf.dtype)
    return pooled - buf[:, start:]


def causal_dwconv(buf, n_new, w, b):
    y = b
    for k in range(CONV_K):
        y = y + buf[:, k:k + n_new] * w[k]
    return y


def layer(x, c, pool_prefix, conv_prefix, pos0, w_ada, b_ada, norm1, ffn1_gate, ffn1_up, ffn1_down,
          norm2, w_in, pool_grp, pool_scale, w_branch_a, conv_w, conv_b, w_branch_b, w_o,
          norm3, ffn2_gate, ffn2_up, ffn2_down):
    B, T, _ = x.shape
    mod = jax.nn.silu(c) @ w_ada + b_ada
    sh1, sc1, g1, sh2, sc2, g2, sh3, sc3, g3 = jnp.split(mod, N_MOD, axis=-1)
    h = modulate(x, norm1, sh1, sc1)
    x = x + 0.5 * g1[:, None, :] * swiglu(h, ffn1_gate, ffn1_up, ffn1_down)
    h = modulate(x, norm2, sh2, sc2)
    z = h @ w_in
    p, cb, cc, ch, ga, gb = jnp.split(z, [POOL_WIDTH, POOL_WIDTH + CONV_WIDTH, POOL_WIDTH + 2 * CONV_WIDTH,
                                         POOL_WIDTH + 3 * CONV_WIDTH, POOL_WIDTH + 3 * CONV_WIDTH + D_MODEL], axis=-1)
    pool_buf = jnp.concatenate([pool_prefix, p], axis=1)
    a = multiscale_pool(pool_buf, T, pos0)
    a = jnp.einsum('btgc,gcd->btgd', a.reshape(B, T, POOL_GROUPS, POOL_GROUP_DIM), pool_grp)
    a = a.reshape(B, T, POOL_WIDTH) * pool_scale
    ua = a @ w_branch_a
    conv_buf = jnp.concatenate([conv_prefix, cc * ch], axis=1)
    v = cb * causal_dwconv(conv_buf, T, conv_w, conv_b)
    ub = v @ w_branch_b
    m = jax.nn.sigmoid(ga) * ua + jax.nn.sigmoid(gb) * ub
    x = x + g2[:, None, :] * (m @ w_o)
    h = modulate(x, norm3, sh3, sc3)
    x = x + 0.5 * g3[:, None, :] * swiglu(h, ffn2_gate, ffn2_up, ffn2_down)
    return x, pool_buf[:, -POOL_STATE:], conv_buf[:, -CONV_STATE:]


def setup_inputs(seed: int = 0) -> dict:
    key = jax.random.key(seed)
    ks = jax.random.split(key, 32)
    f32 = jnp.float32
    def nrm(k, shape, scale):
        return jax.random.normal(k, shape, f32) * scale
    L = DEPTH
    return {
        "x_prompt": nrm(ks[0], (BATCH, SEQ, D_MODEL), 1.0),
        "x_sample": nrm(ks[1], (DEC_BATCH, DEC_SEQ, D_MODEL), 1.0),
        "c_prompt": nrm(ks[2], (BATCH, D_MODEL), 1.0),
        "c_sample": nrm(ks[3], (DEC_BATCH, D_MODEL), 1.0),
        "state_pool": nrm(ks[4], (L, DEC_BATCH, POOL_STATE, POOL_WIDTH), 1.0),
        "state_conv": nrm(ks[5], (L, DEC_BATCH, CONV_STATE, CONV_WIDTH), 1.0),
        "w_ada": nrm(ks[6], (L, D_MODEL, N_MOD * D_MODEL), 0.5 * D_MODEL ** -0.5),
        "b_ada": nrm(ks[7], (L, N_MOD * D_MODEL), 0.02),
        "norm1": 1.0 + nrm(ks[8], (L, D_MODEL), 0.02),
        "ffn1_gate": nrm(ks[9], (L, D_MODEL, D_FF), D_MODEL ** -0.5),
        "ffn1_up": nrm(ks[10], (L, D_MODEL, D_FF), D_MODEL ** -0.5),
        "ffn1_down": nrm(ks[11], (L, D_FF, D_MODEL), D_FF ** -0.5),
        "norm2": 1.0 + nrm(ks[12], (L, D_MODEL), 0.02),
        "w_in": nrm(ks[13], (L, D_MODEL, IN_COLS), D_MODEL ** -0.5),
        "pool_grp": nrm(ks[14], (L, POOL_GROUPS, POOL_GROUP_DIM, POOL_GROUP_DIM), POOL_GROUP_DIM ** -0.5),
        "pool_scale": 1.0 + nrm(ks[15], (L, POOL_WIDTH), 0.02),
        "w_branch_a": nrm(ks[16], (L, POOL_WIDTH, D_MODEL), POOL_WIDTH ** -0.5),
        "conv_w": nrm(ks[17], (L, CONV_K, CONV_WIDTH), CONV_K ** -0.5),
        "conv_b": nrm(ks[18], (L, CONV_WIDTH), 0.02),
        "w_branch_b": nrm(ks[19], (L, CONV_WIDTH, D_MODEL), CONV_WIDTH ** -0.5),
        "w_o": nrm(ks[20], (L, D_MODEL, D_MODEL), D_MODEL ** -0.5),
        "norm3": 1.0 + nrm(ks[21], (L, D_MODEL), 0.02),
        "ffn2_gate": nrm(ks[22], (L, D_MODEL, D_FF), D_MODEL ** -0.5),
        "ffn2_up": nrm(ks[23], (L, D_MODEL, D_FF), D_MODEL ** -0.5),
        "ffn2_down": nrm(ks[24], (L, D_FF, D_MODEL), D_FF ** -0.5),
        "norm_final": 1.0 + nrm(ks[25], (D_MODEL,), 0.02),
    }


def reference(x_prompt, x_sample, c_prompt, c_sample, state_pool, state_conv, w_ada, b_ada, norm1,
              ffn1_gate, ffn1_up, ffn1_down, norm2, w_in, pool_grp, pool_scale, w_branch_a, conv_w, conv_b,
              w_branch_b, w_o, norm3, ffn2_gate, ffn2_up, ffn2_down, norm_final):
    xp, xs = x_prompt, x_sample
    pool_p, conv_p, pool_s, conv_s = [], [], [], []
    for d in range(DEPTH):
        params = (w_ada[d], b_ada[d], norm1[d], ffn1_gate[d], ffn1_up[d], ffn1_down[d], norm2[d], w_in[d],
                  pool_grp[d], pool_scale[d], w_branch_a[d], conv_w[d], conv_b[d], w_branch_b[d], w_o[d],
                  norm3[d], ffn2_gate[d], ffn2_up[d], ffn2_down[d])
        zp_pool = jnp.zeros((xp.shape[0], POOL_STATE, POOL_WIDTH), xp.dtype)
        zp_conv = jnp.zeros((xp.shape[0], CONV_STATE, CONV_WIDTH), xp.dtype)
        xp, np_, nc_ = layer(xp, c_prompt, zp_pool, zp_conv, 0, *params)
        xs, ns_, ncs_ = layer(xs, c_sample, state_pool[d], state_conv[d], PAST_LEN, *params)
        pool_p.append(np_); conv_p.append(nc_); pool_s.append(ns_); conv_s.append(ncs_)
    y_prompt = rmsnorm(xp, norm_final)
    y_sample = rmsnorm(xs, norm_final)
    new_pool_prompt = jnp.stack(pool_p, axis=0)
    new_conv_prompt = jnp.stack(conv_p, axis=0)
    new_pool_sample = jnp.stack(pool_s, axis=0)
    new_conv_sample = jnp.stack(conv_s, axis=0)
    return (y_prompt, y_sample, new_pool_prompt, new_conv_prompt, new_pool_sample, new_conv_sample)
```

```cpp
#include <hip/hip_runtime.h>
#include <hip/hip_cooperative_groups.h>
#include <cstdio>
#include <cstdint>
#ifndef ONE_LAUNCH
#define ONE_LAUNCH 1
#endif
namespace cg = cooperative_groups;

#define LAS __attribute__((address_space(3)))
typedef unsigned short bf16_t;
typedef short bf16x8 __attribute__((ext_vector_type(8)));
typedef float f32x4 __attribute__((ext_vector_type(4)));
typedef unsigned u32x4 __attribute__((ext_vector_type(4)));
typedef unsigned u32x2 __attribute__((ext_vector_type(2)));

constexpr int D = 2048, FF = 5632, NP = 8192, NS = 128, MR = NP + NS, MP = 8448, NMT = MP / 256;
constexpr int INC = 8192, PW = 1024, CWD = 1024, NMOD = 9 * D, SEQ = 2048, NB = 4;
constexpr float EPS = 1e-6f;
constexpr int NTHREADS = 512;
constexpr int LDS_BYTES = 131072;

constexpr size_t al256(size_t x) { return (x + 255) & ~(size_t)255; }
constexpr size_t WS_WGU1 = 0;
constexpr size_t WS_WD1 = WS_WGU1 + (size_t)2 * FF * D * 2;
constexpr size_t WS_WIN = WS_WD1 + (size_t)D * FF * 2;
constexpr size_t WS_WGRP = WS_WIN + (size_t)INC * D * 2;
constexpr size_t WS_WA = WS_WGRP + (size_t)PW * 256 * 2;
constexpr size_t WS_WB = WS_WA + (size_t)D * PW * 2;
constexpr size_t WS_WO = WS_WB + (size_t)D * CWD * 2;
constexpr size_t WS_WGU2 = WS_WO + (size_t)D * D * 2;
constexpr size_t WS_WD2 = WS_WGU2 + (size_t)2 * FF * D * 2;
constexpr size_t WS_MOD = WS_WD2 + (size_t)D * FF * 2;
constexpr size_t WS_CS = WS_MOD + (size_t)256 * NMOD * 4;
constexpr size_t WS_H = WS_CS + (size_t)256 * D * 2;
constexpr size_t WS_XR = WS_H + (size_t)MP * D * 2;
constexpr size_t WS_R1 = WS_XR + (size_t)MP * D * 4;
constexpr size_t R1_BYTES = (size_t)MP * FF * 2;
constexpr size_t WS_P = WS_R1;
constexpr size_t WS_U = WS_P + (size_t)MP * PW * 4;
constexpr size_t WS_CB = WS_U + (size_t)MP * CWD * 4;
static_assert(WS_CB + (size_t)MP * CWD * 2 <= WS_R1 + R1_BYTES, "R1 overlay");
static_assert((size_t)NMOD * D * 2 <= R1_BYTES, "Wada overlay");
constexpr size_t WS_SGA = WS_R1 + R1_BYTES;
constexpr size_t WS_SGB = WS_SGA + (size_t)MP * D * 2;
constexpr size_t WS_AIN = WS_SGB + (size_t)MP * D * 2;
constexpr size_t WS_AP = WS_AIN + (size_t)MP * PW * 2;
constexpr size_t WS_V = WS_AP + (size_t)MP * PW * 2;
constexpr size_t WS_TA = WS_V + (size_t)MP * CWD * 2;
constexpr size_t WS_CTL = WS_TA + (size_t)MP * D * 2;
constexpr size_t WS_END = WS_CTL + 256;

typedef float f32x2_t __attribute__((ext_vector_type(2)));
typedef __bf16 bf16x2_t __attribute__((ext_vector_type(2)));
__device__ __forceinline__ unsigned cvt_pk_bf16(float lo, float hi) { const f32x2_t v = {lo, hi}; const bf16x2_t b = __builtin_convertvector(v, bf16x2_t); return __builtin_bit_cast(unsigned, b); }
__device__ __forceinline__ u32x4 pack8(f32x4 a, f32x4 b) { u32x4 w; w.x = cvt_pk_bf16(a[0], a[1]); w.y = cvt_pk_bf16(a[2], a[3]); w.z = cvt_pk_bf16(b[0], b[1]); w.w = cvt_pk_bf16(b[2], b[3]); return w; }
__device__ __forceinline__ void unpack8(u32x4 w, f32x4& a, f32x4& b) {
    a[0] = __uint_as_float(w.x << 16); a[1] = __uint_as_float(w.x & 0xffff0000u); a[2] = __uint_as_float(w.y << 16); a[3] = __uint_as_float(w.y & 0xffff0000u);
    b[0] = __uint_as_float(w.z << 16); b[1] = __uint_as_float(w.z & 0xffff0000u); b[2] = __uint_as_float(w.w << 16); b[3] = __uint_as_float(w.w & 0xffff0000u); }
__device__ __forceinline__ float sigm_f(float x) { return __builtin_amdgcn_rcpf(1.0f + __expf(-x)); }
__device__ __forceinline__ float silu_f(float x) { return x * sigm_f(x); }
__device__ __forceinline__ int lane_id_v() { int l; asm volatile("v_mbcnt_lo_u32_b32 %0, -1, 0\n\tv_mbcnt_hi_u32_b32 %0, -1, %0" : "=v"(l)); return l; }
__device__ __forceinline__ int bidx(int row) { return row < NP ? (row >> 11) : (row - NP + NB); }

namespace pg8 {
constexpr int BM = 256, BK = 64, HALF = 128, HTB = HALF * BK * 2, STAGE_BYTES = 8 * HTB, NXCD = 8, WGM = 8;
__host__ __device__ __forceinline__ int lds_byte(int r, int c) { const int st = (r >> 4) * 2 + (c >> 5), rr = r & 15, cc = c & 31, ob = rr * 64 + cc * 2; return st * 1024 + (ob ^ (((ob >> 9) & 1) << 5)); }
__host__ __device__ __forceinline__ void stage_rc(int b, int& R, int& C) { const int st = b / 1024, sb = b % 1024, swz = sb ^ (((sb >> 9) & 1) << 5); R = (st >> 1) * 16 + swz / 64; C = (st & 1) * 32 + (swz % 64) / 2; }
__host__ __device__ __forceinline__ int perm32(int rho) { const int n = rho >> 4, i = rho & 15; return 8 * (i >> 2) + 4 * n + (i & 3); }

struct Unit { int pm, pn; };
struct Gemm { const bf16_t* A; const bf16_t* Bt; int lda, K, a_pn_off; };

struct StaticOrder {
    int nM, nN, nwg, G, c;
    __device__ void init(int nM_, int nN_, int G_, int c_) { nM = nM_; nN = nN_; nwg = nM * nN; G = G_; c = c_; }
    __device__ bool next(int i, Unit& u) const {
        const long L = (long)i * G + c; if (L >= nwg) return false;
        int wgid = (int)L; { const int q = nwg / NXCD, r = nwg % NXCD, xcd = wgid % NXCD, off = wgid / NXCD; wgid = (xcd < r ? xcd * (q + 1) : r * (q + 1) + (xcd - r) * q) + off; }
        const int nig = WGM * nN, gid = wgid / nig, fm = gid * WGM, gsz = (nM - fm) < WGM ? (nM - fm) : WGM;
        u.pm = fm + ((wgid % nig) % gsz); u.pn = (wgid % nig) / gsz; return true;
    }
};

template <class Epi>
__device__ __forceinline__ void gemm_phase(LAS unsigned char* lds, const Gemm g, const StaticOrder& S, const Epi& E, const int wid) {
    const int lane = lane_id_v(), tid = wid * 64 + lane, wr = wid >> 2, wc = wid & 3, fr = lane & 15, fq = lane >> 4;
    const int K = g.K, nt = K / BK, lda = g.lda;
    unsigned voffA[2], voffB[2];
#pragma unroll
    for (int i = 0; i < 2; ++i) { int R, C; stage_rc(tid * 16 + i * 8192, R, C); const int Rb = (R & ~31) + perm32(R & 31);
        voffA[i] = (unsigned)(R * lda + C) * 2u; voffB[i] = (unsigned)(Rb * K + C) * 2u; }
    const size_t kstep = (size_t)(BK * 2);
    const size_t hstepA = (size_t)HALF * lda * 2, tstepA = 2 * hstepA;
    const size_t hstepB = (size_t)HALF * K * 2, tstepB = 2 * hstepB;
    const size_t pnA = (size_t)g.a_pn_off * 2;
    const unsigned ldsw = (unsigned)wid * 1024u;
    const int aoff = lds_byte(wr * 64 + fr, fq * 8), boff = lds_byte(wc * 32 + fr, fq * 8);
#define PG8_SA(b, h) (((b) * 2 + (h)) * HTB)
#define PG8_SB(b, h) ((4 + (b) * 2 + (h)) * HTB)
#define PG8_STAGE(bufoff, gbase, voff) do { _Pragma("unroll") for (int _i = 0; _i < 2; ++_i) \
        __builtin_amdgcn_global_load_lds((const unsigned*)((const char*)(gbase) + (voff)[_i]), (LAS unsigned*)(lds + (bufoff) + ldsw + _i * 8192), 16, 0, 0); } while (0)
#define PG8_LDA(dst, b, h) do { _Pragma("unroll") for (int m = 0; m < 4; ++m) _Pragma("unroll") for (int k = 0; k < 2; ++k) dst[m][k] = *(const LAS bf16x8*)(lds + PG8_SA(b, h) + aoff + m * 2048 + k * 1024); } while (0)
#define PG8_LDB(dst, b, h) do { _Pragma("unroll") for (int n = 0; n < 2; ++n) _Pragma("unroll") for (int k = 0; k < 2; ++k) dst[n][k] = *(const LAS bf16x8*)(lds + PG8_SB(b, h) + boff + n * 2048 + k * 1024); } while (0)
#define PG8_MMA(ai, bj, At, Bt) do { __builtin_amdgcn_s_setprio(1); _Pragma("unroll") for (int m = 0; m < 4; ++m) _Pragma("unroll") for (int n = 0; n < 2; ++n) _Pragma("unroll") for (int k = 0; k < 2; ++k) \
        acc[ai][bj][m][n] = __builtin_amdgcn_mfma_f32_16x16x32_bf16(Bt[n][k], At[m][k], acc[ai][bj][m][n], 0, 0, 0); __builtin_amdgcn_s_setprio(0); } while (0)
#define PG8_WAIT_V(n) asm volatile("s_waitcnt vmcnt(" #n ")" ::: "memory")
#define PG8_WAIT_L(n) asm volatile("s_waitcnt lgkmcnt(" #n ")" ::: "memory")
#define PG8_BAR __builtin_amdgcn_s_barrier()
#define PG8_SCHED __builtin_amdgcn_sched_barrier(0)
    Unit cur, nxt; int ui = 0;
    if (!S.next(0, cur)) return;
    f32x4 acc[2][2][4][2];
#pragma unroll
    for (int a = 0; a < 2; ++a)
#pragma unroll
        for (int b = 0; b < 2; ++b)
#pragma unroll
            for (int m = 0; m < 4; ++m)
#pragma unroll
                for (int n = 0; n < 2; ++n) acc[a][b][m][n] = (f32x4){0.f, 0.f, 0.f, 0.f};
    bf16x8 At[4][2], B0[2][2], B1[2][2];
    const char* cA = (const char*)g.A + (size_t)cur.pm * tstepA + (size_t)cur.pn * pnA; const char* cB = (const char*)g.Bt + (size_t)cur.pn * tstepB;
    PG8_STAGE(PG8_SB(0, 0), cB, voffB); PG8_STAGE(PG8_SB(0, 1), cB + hstepB, voffB); PG8_STAGE(PG8_SA(0, 0), cA, voffA); PG8_STAGE(PG8_SA(0, 1), cA + hstepA, voffA);
    if (wr == 1) PG8_BAR;
    PG8_WAIT_V(2); PG8_BAR;
    PG8_STAGE(PG8_SB(1, 0), cB + kstep, voffB); PG8_STAGE(PG8_SA(1, 0), cA + kstep, voffA); PG8_STAGE(PG8_SB(1, 1), cB + hstepB + kstep, voffB);
    PG8_WAIT_V(6); PG8_BAR;
    for (;;) {
        const bool has_next = S.next(ui + 1, nxt);
        const char* nA = has_next ? (const char*)g.A + (size_t)nxt.pm * tstepA + (size_t)nxt.pn * pnA : cA; const char* nB = has_next ? (const char*)g.Bt + (size_t)nxt.pn * tstepB : cB;
        for (int t = 0; t < nt; t += 2) {
            const bool last = (t == nt - 2);
            const char* a1 = cA + (size_t)(t + 1) * kstep;
            const char* a2 = last ? nA : cA + (size_t)(t + 2) * kstep; const char* b2 = last ? nB : cB + (size_t)(t + 2) * kstep;
            const char* a3 = a2 + kstep; const char* b3 = b2 + kstep;
            PG8_LDB(B0, 0, 0); PG8_LDB(B1, 0, 1); PG8_SCHED; PG8_LDA(At, 0, 0); PG8_STAGE(PG8_SA(1, 1), a1 + hstepA, voffA);
            PG8_WAIT_V(8); PG8_WAIT_L(0); PG8_BAR; PG8_MMA(0, 0, At, B0); PG8_MMA(0, 1, At, B1); PG8_BAR; PG8_SCHED;
            PG8_LDA(At, 0, 1); PG8_STAGE(PG8_SB(0, 0), b2, voffB); PG8_STAGE(PG8_SB(0, 1), b2 + hstepB, voffB); PG8_STAGE(PG8_SA(0, 0), a2, voffA);
            PG8_WAIT_V(8); PG8_WAIT_L(0); PG8_BAR; PG8_MMA(1, 0, At, B0); PG8_MMA(1, 1, At, B1); PG8_BAR; PG8_SCHED;
            PG8_LDB(B0, 1, 0); PG8_LDB(B1, 1, 1); PG8_SCHED; PG8_LDA(At, 1, 0); PG8_STAGE(PG8_SA(0, 1), a2 + hstepA, voffA);
            PG8_WAIT_V(8); PG8_WAIT_L(0); PG8_BAR; PG8_MMA(0, 0, At, B0); PG8_MMA(0, 1, At, B1); PG8_BAR; PG8_SCHED;
            PG8_LDA(At, 1, 1); PG8_STAGE(PG8_SB(1, 0), b3, voffB); PG8_STAGE(PG8_SB(1, 1), b3 + hstepB, voffB); PG8_STAGE(PG8_SA(1, 0), a3, voffA);
            PG8_WAIT_V(8); PG8_WAIT_L(0); PG8_BAR; PG8_MMA(1, 0, At, B0); PG8_MMA(1, 1, At, B1); PG8_BAR; PG8_SCHED;
        }
        if (wr == 0) PG8_BAR;
        { const int el = lane_id_v(); E(acc, cur, wr, wc, el & 15, el >> 4); }
        if (!has_next) break;
#pragma unroll
        for (int a = 0; a < 2; ++a)
#pragma unroll
            for (int b = 0; b < 2; ++b)
#pragma unroll
                for (int m = 0; m < 4; ++m)
#pragma unroll
                    for (int n = 0; n < 2; ++n) acc[a][b][m][n] = (f32x4){0.f, 0.f, 0.f, 0.f};
        cur = nxt; cA = nA; cB = nB; ++ui;
        if (wr == 1) PG8_BAR;
    }
    PG8_WAIT_V(0);
    PG8_BAR;
#undef PG8_SA
#undef PG8_SB
#undef PG8_STAGE
#undef PG8_LDA
#undef PG8_LDB
#undef PG8_MMA
#undef PG8_WAIT_V
#undef PG8_WAIT_L
#undef PG8_BAR
#undef PG8_SCHED
}
}

using pg8::Unit;
typedef f32x4 AccT[2][2][4][2];
#define EPI_ROW(u, ai, m) ((u).pm * 256 + (ai) * 128 + wr * 64 + (m) * 16 + fr)
#define EPI_COL(u, bj) ((u).pn * 256 + (bj) * 128 + wc * 32 + fq * 8)

struct EpiMod {
    float* mod; const float* bias;
    __device__ __forceinline__ void operator()(const AccT& acc, const Unit& u, int wr, int wc, int fr, int fq) const {
#pragma unroll
        for (int bj = 0; bj < 2; ++bj) { const int col = EPI_COL(u, bj); const f32x4 b0 = *(const f32x4*)(bias + col), b1 = *(const f32x4*)(bias + col + 4);
#pragma unroll
            for (int ai = 0; ai < 2; ++ai)
#pragma unroll
                for (int m = 0; m < 4; ++m) { float* p = mod + (size_t)EPI_ROW(u, ai, m) * NMOD + col; *(f32x4*)p = acc[ai][bj][m][0] + b0; *(f32x4*)(p + 4) = acc[ai][bj][m][1] + b1; } }
    }
};
struct EpiGU {
    bf16_t* act;
    __device__ __forceinline__ void operator()(const AccT& acc, const Unit& u, int wr, int wc, int fr, int fq) const {
#pragma unroll
        for (int ai = 0; ai < 2; ++ai)
#pragma unroll
            for (int m = 0; m < 4; ++m) { f32x4 o[2];
#pragma unroll
                for (int n = 0; n < 2; ++n)
#pragma unroll
                    for (int j = 0; j < 4; ++j) o[n][j] = silu_f(acc[ai][0][m][n][j]) * acc[ai][1][m][n][j];
                *(u32x4*)(act + (size_t)EPI_ROW(u, ai, m) * FF + u.pn * 128 + wc * 32 + fq * 8) = pack8(o[0], o[1]); }
    }
};
struct EpiRes {
    const float* baseP; const float* baseS; float* out; const float* gate; float gs;
    __device__ __forceinline__ void operator()(const AccT& acc, const Unit& u, int wr, int wc, int fr, int fq) const {
#pragma unroll
        for (int ai = 0; ai < 2; ++ai)
#pragma unroll
            for (int m = 0; m < 4; ++m) { const int row = EPI_ROW(u, ai, m);
                if (row < MR) { const float* bp = row < NP ? baseP + (size_t)row * D : baseS + (size_t)(row - NP) * D; const float* gp = gate + (size_t)bidx(row) * NMOD; float* op = out + (size_t)row * D;
#pragma unroll
                    for (int bj = 0; bj < 2; ++bj) { const int col = EPI_COL(u, bj);
#pragma unroll
                        for (int n = 0; n < 2; ++n) { const f32x4 b = *(const f32x4*)(bp + col + 4 * n), gg = *(const f32x4*)(gp + col + 4 * n); *(f32x4*)(op + col + 4 * n) = b + gs * gg * acc[ai][bj][m][n]; } } }
                asm volatile("" ::: "memory"); }
    }
};
struct EpiWin {
    float* P; bf16_t* CB; float* U; bf16_t* SGA; bf16_t* SGB;
    __device__ __forceinline__ void operator()(const AccT& acc, const Unit& u, int wr, int wc, int fr, int fq) const {
        const int pn = u.pn;
        if (pn < 4) {
#pragma unroll
            for (int ai = 0; ai < 2; ++ai)
#pragma unroll
                for (int m = 0; m < 4; ++m) { float* p = P + (size_t)EPI_ROW(u, ai, m) * PW;
#pragma unroll
                    for (int bj = 0; bj < 2; ++bj) { const int col = EPI_COL(u, bj); *(f32x4*)(p + col) = acc[ai][bj][m][0]; *(f32x4*)(p + col + 4) = acc[ai][bj][m][1]; } }
        } else if (pn < 8) {
#pragma unroll
            for (int ai = 0; ai < 2; ++ai)
#pragma unroll
                for (int m = 0; m < 4; ++m) { bf16_t* p = CB + (size_t)EPI_ROW(u, ai, m) * CWD - 1024;
#pragma unroll
                    for (int bj = 0; bj < 2; ++bj) *(u32x4*)(p + EPI_COL(u, bj)) = pack8(acc[ai][bj][m][0], acc[ai][bj][m][1]); }
        } else if (pn < 16) {
#pragma unroll
            for (int ai = 0; ai < 2; ++ai)
#pragma unroll
                for (int m = 0; m < 4; ++m) { float* p = U + (size_t)EPI_ROW(u, ai, m) * CWD + (pn - 8) * 128 + wc * 32 + fq * 8;
                    *(f32x4*)p = acc[ai][0][m][0] * acc[ai][1][m][0]; *(f32x4*)(p + 4) = acc[ai][0][m][1] * acc[ai][1][m][1]; }
        } else {
            bf16_t* base = pn < 24 ? SGA - 4096 : SGB - 6144;
#pragma unroll
            for (int ai = 0; ai < 2; ++ai)
#pragma unroll
                for (int m = 0; m < 4; ++m) { bf16_t* p = base + (size_t)EPI_ROW(u, ai, m) * D;
#pragma unroll
                    for (int bj = 0; bj < 2; ++bj) { f32x4 o[2];
#pragma unroll
                        for (int n = 0; n < 2; ++n)
#pragma unroll
                            for (int j = 0; j < 4; ++j) o[n][j] = sigm_f(acc[ai][bj][m][n][j]);
                        *(u32x4*)(p + EPI_COL(u, bj)) = pack8(o[0], o[1]); } }
        }
    }
};
struct EpiGrp {
    bf16_t* AP; const float* scale;
    __device__ __forceinline__ void operator()(const AccT& acc, const Unit& u, int wr, int wc, int fr, int fq) const {
#pragma unroll
        for (int bj = 0; bj < 2; ++bj) { const int col = EPI_COL(u, bj); const f32x4 s0 = *(const f32x4*)(scale + col), s1 = *(const f32x4*)(scale + col + 4);
#pragma unroll
            for (int ai = 0; ai < 2; ++ai)
#pragma unroll
                for (int m = 0; m < 4; ++m) *(u32x4*)(AP + (size_t)EPI_ROW(u, ai, m) * PW + col) = pack8(acc[ai][bj][m][0] * s0, acc[ai][bj][m][1] * s1); }
    }
};
template <int MODE> struct EpiBr {
    const bf16_t* SG; bf16_t* TA; bf16_t* MO;
    __device__ __forceinline__ void operator()(const AccT& acc, const Unit& u, int wr, int wc, int fr, int fq) const {
#pragma unroll
        for (int ai = 0; ai < 2; ++ai)
#pragma unroll
            for (int m = 0; m < 4; ++m) { const size_t ro = (size_t)EPI_ROW(u, ai, m) * D;
#pragma unroll
                for (int bj = 0; bj < 2; ++bj) { const size_t o = ro + EPI_COL(u, bj); f32x4 s0, s1; unpack8(*(const u32x4*)(SG + o), s0, s1);
                    f32x4 r0 = s0 * acc[ai][bj][m][0], r1 = s1 * acc[ai][bj][m][1];
                    if (MODE == 1) { f32x4 t0, t1; unpack8(*(const u32x4*)(TA + o), t0, t1); r0 += t0; r1 += t1; *(u32x4*)(MO + o) = pack8(r0, r1); }
                    else *(u32x4*)(TA + o) = pack8(r0, r1); }
                asm volatile("" ::: "memory"); }
    }
};

struct Args { const float* in[26]; float* out; unsigned char* ws; int ph_lo, ph_hi; };

__device__ __forceinline__ int map_row(int map, int n) {
    if (map == 1) return (n >> 7) * 256 + (n & 127);
    if (map == 2) return (n >> 7) * 256 + 128 + (n & 127);
    if (map == 3) { if (n < 2048 || n >= 4096) return n; if (n < 3072) { const int j = n - 2048; return 2048 + (j >> 7) * 256 + (j & 127); } const int j = n - 3072; return 2048 + (j >> 7) * 256 + 128 + (j & 127); }
    return n;
}
__device__ void cvt_task(LAS unsigned* T, const float* src, bf16_t* dst, int K, int N, int dstK, int map, int& base, int G, int tid) {
    const int tn = N / 64, ntiles = (K / 128) * tn;
    const int nq = tid & 15, kp = tid >> 4;
    int first = ((int)blockIdx.x - base % G + G) % G;
    for (int t = first; t < ntiles; t += G) {
        const int kt = t / tn, ntile = t - kt * tn, k0 = kt * 128, n0 = ntile * 64;
        f32x4 r[2][2];
#pragma unroll
        for (int it = 0; it < 2; ++it) { const int k = k0 + 2 * (kp + 32 * it); r[it][0] = *(const f32x4*)(src + (size_t)k * N + n0 + nq * 4); r[it][1] = *(const f32x4*)(src + (size_t)(k + 1) * N + n0 + nq * 4); }
#pragma unroll
        for (int it = 0; it < 2; ++it) { const int kk = kp + 32 * it;
#pragma unroll
            for (int j = 0; j < 4; ++j) T[(nq * 4 + j) * 65 + kk] = cvt_pk_bf16(r[it][0][j], r[it][1][j]); }
        __syncthreads();
        const int n0d = map_row(map, n0);
#pragma unroll
        for (int ps = 0; ps < 2; ++ps) { const int nl = (tid >> 4) + 32 * ps, kq = tid & 15; u32x4 w;
            w.x = T[nl * 65 + kq * 4 + 0]; w.y = T[nl * 65 + kq * 4 + 1]; w.z = T[nl * 65 + kq * 4 + 2]; w.w = T[nl * 65 + kq * 4 + 3];
            *(u32x4*)(dst + (size_t)(n0d + nl) * dstK + k0 + kq * 8) = w; }
        __syncthreads();
    }
    base += ntiles;
}

__device__ void p0_prologue(const Args& a, LAS unsigned char* lds, int G, int wid) {
    const int tid = wid * 64 + lane_id_v();
    unsigned char* ws = a.ws; LAS unsigned* T = (LAS unsigned*)lds; int base = 0;
    cvt_task(T, a.in[6], (bf16_t*)(ws + WS_R1), D, NMOD, D, 0, base, G, tid);
    cvt_task(T, a.in[9], (bf16_t*)(ws + WS_WGU1), D, FF, D, 1, base, G, tid);
    cvt_task(T, a.in[10], (bf16_t*)(ws + WS_WGU1), D, FF, D, 2, base, G, tid);
    cvt_task(T, a.in[11], (bf16_t*)(ws + WS_WD1), FF, D, FF, 0, base, G, tid);
    cvt_task(T, a.in[13], (bf16_t*)(ws + WS_WIN), D, INC, D, 3, base, G, tid);
    for (int g = 0; g < 4; ++g) cvt_task(T, a.in[14] + (size_t)g * 65536, (bf16_t*)(ws + WS_WGRP) + (size_t)g * 65536, 256, 256, 256, 0, base, G, tid);
    cvt_task(T, a.in[16], (bf16_t*)(ws + WS_WA), PW, D, PW, 0, base, G, tid);
    cvt_task(T, a.in[19], (bf16_t*)(ws + WS_WB), CWD, D, CWD, 0, base, G, tid);
    cvt_task(T, a.in[20], (bf16_t*)(ws + WS_WO), D, D, D, 0, base, G, tid);
    cvt_task(T, a.in[22], (bf16_t*)(ws + WS_WGU2), D, FF, D, 1, base, G, tid);
    cvt_task(T, a.in[23], (bf16_t*)(ws + WS_WGU2), D, FF, D, 2, base, G, tid);
    cvt_task(T, a.in[24], (bf16_t*)(ws + WS_WD2), FF, D, FF, 0, base, G, tid);
    bf16_t* cs = (bf16_t*)(ws + WS_CS);
    for (int i = blockIdx.x * NTHREADS + tid; i < 256 * D / 4; i += G * NTHREADS) { const int row = i / (D / 4), c4 = (i - row * (D / 4)) * 4; u32x2 w = {0u, 0u};
        if (row < NB + NS) { const float* cp = row < NB ? a.in[2] + (size_t)row * D : a.in[3] + (size_t)(row - NB) * D; const f32x4 v = *(const f32x4*)(cp + c4);
            w.x = cvt_pk_bf16(silu_f(v[0]), silu_f(v[1])); w.y = cvt_pk_bf16(silu_f(v[2]), silu_f(v[3])); }
        *(u32x2*)(cs + (size_t)row * D + c4) = w; }
}

__device__ __forceinline__ float wave_sum(float s) {
#pragma unroll
    for (int o = 32; o >= 1; o >>= 1) s += __shfl_xor(s, o);
    return s;
}
__device__ void rowmod_phase(const float* srcP, const float* srcS, const float* normw, const float* mod, int jsh, bf16_t* h, int G, int wid) {
    const int lane = lane_id_v();
    for (int row = blockIdx.x * 8 + wid; row < MR; row += G * 8) {
        const float* src = row < NP ? srcP + (size_t)row * D : srcS + (size_t)(row - NP) * D;
        const float* sh = mod + (size_t)bidx(row) * NMOD + (size_t)jsh * D; const float* sc = sh + D;
        f32x4 v[8]; float ss = 0.f;
#pragma unroll
        for (int i = 0; i < 8; ++i) { v[i] = *(const f32x4*)(src + (i * 64 + lane) * 4); ss += v[i][0] * v[i][0] + v[i][1] * v[i][1] + v[i][2] * v[i][2] + v[i][3] * v[i][3]; }
        ss = wave_sum(ss); const float inv = rsqrtf(ss * (1.0f / D) + EPS);
#pragma unroll
        for (int i = 0; i < 8; ++i) { const int c = (i * 64 + lane) * 4; const f32x4 g4 = *(const f32x4*)(normw + c), s4 = *(const f32x4*)(sc + c), h4 = *(const f32x4*)(sh + c);
            const f32x4 o = (v[i] * inv) * g4 * (1.0f + s4) + h4; u32x2 w; w.x = cvt_pk_bf16(o[0], o[1]); w.y = cvt_pk_bf16(o[2], o[3]); *(u32x2*)(h + (size_t)row * D + c) = w; }
    }
}
__device__ void final_norm_phase(const float* xr, const float* normw, float* out, int G, int wid) {
    const int lane = lane_id_v();
    for (int row = blockIdx.x * 8 + wid; row < MR; row += G * 8) {
        const float* src = xr + (size_t)row * D; f32x4 v[8]; float ss = 0.f;
#pragma unroll
        for (int i = 0; i < 8; ++i) { v[i] = *(const f32x4*)(src + (i * 64 + lane) * 4); ss += v[i][0] * v[i][0] + v[i][1] * v[i][1] + v[i][2] * v[i][2] + v[i][3] * v[i][3]; }
        ss = wave_sum(ss); const float inv = rsqrtf(ss * (1.0f / D) + EPS);
#pragma unroll
        for (int i = 0; i < 8; ++i) { const int c = (i * 64 + lane) * 4; *(f32x4*)(out + (size_t)row * D + c) = (v[i] * inv) * *(const f32x4*)(normw + c); }
    }
}
__device__ void mixer_phase(const Args& a, int G, int wid) {
    unsigned char* ws = a.ws;
    const float* P = (const float*)(ws + WS_P); const float* U = (const float*)(ws + WS_U); const bf16_t* CB = (const bf16_t*)(ws + WS_CB);
    bf16_t* AIN = (bf16_t*)(ws + WS_AIN); bf16_t* V = (bf16_t*)(ws + WS_V);
    const float* state_pool = a.in[4]; const float* state_conv = a.in[5]; const float* conv_w = a.in[17]; const float* conv_b = a.in[18];
    float* o_pp = a.out + (size_t)MR * D; float* o_cp = o_pp + (size_t)NB * 15 * PW; float* o_ps = o_cp + (size_t)NB * 2 * CWD; float* o_cs = o_ps + (size_t)NS * 15 * PW;
    const int rpb = (MR + G - 1) / G, r0 = blockIdx.x * rpb, r1 = (r0 + rpb) < MR ? (r0 + rpb) : MR;
    const int tid = wid * 64 + lane_id_v();
    if (wid < 4) {
        const int c = tid * 4, g = tid >> 6, w = 2 << g;
        for (int row = r0; row < r1; ++row) {
            const f32x4 pc = *(const f32x4*)(P + (size_t)row * PW + c); f32x4 s = pc; int cnt;
            if (row < NP) { const int b = row >> 11, t = row & (SEQ - 1); cnt = (t + 1) < w ? (t + 1) : w;
                for (int i = 1; i < cnt; ++i) s += *(const f32x4*)(P + (size_t)(row - i) * PW + c);
                if (t >= SEQ - 15) *(f32x4*)(o_pp + ((size_t)b * 15 + (t - (SEQ - 15))) * PW + c) = pc;
            } else { const int b = row - NP; cnt = w; const float* sp = state_pool + (size_t)b * 15 * PW + c;
                for (int i = 1; i < w; ++i) s += *(const f32x4*)(sp + (size_t)(15 - i) * PW);
                float* op = o_ps + (size_t)b * 15 * PW + c;
                for (int i = 0; i < 14; ++i) *(f32x4*)(op + (size_t)i * PW) = *(const f32x4*)(sp + (size_t)(i + 1) * PW);
                *(f32x4*)(op + (size_t)14 * PW) = pc; }
            const f32x4 o = s * (1.0f / (float)cnt) - pc; u32x2 wv; wv.x = cvt_pk_bf16(o[0], o[1]); wv.y = cvt_pk_bf16(o[2], o[3]); *(u32x2*)(AIN + (size_t)row * PW + c) = wv;
        }
    } else {
        const int c = (tid - 256) * 4;
        const f32x4 w0 = *(const f32x4*)(conv_w + c), w1 = *(const f32x4*)(conv_w + CWD + c), w2 = *(const f32x4*)(conv_w + 2 * CWD + c), bb = *(const f32x4*)(conv_b + c);
        for (int row = r0; row < r1; ++row) {
            const f32x4 u2 = *(const f32x4*)(U + (size_t)row * CWD + c); f32x4 u1 = {0.f, 0.f, 0.f, 0.f}, u0 = {0.f, 0.f, 0.f, 0.f};
            if (row < NP) { const int b = row >> 11, t = row & (SEQ - 1);
                if (t >= 1) u1 = *(const f32x4*)(U + (size_t)(row - 1) * CWD + c);
                if (t >= 2) u0 = *(const f32x4*)(U + (size_t)(row - 2) * CWD + c);
                if (t >= SEQ - 2) *(f32x4*)(o_cp + ((size_t)b * 2 + (t - (SEQ - 2))) * CWD + c) = u2;
            } else { const int b = row - NP; const float* sp = state_conv + (size_t)b * 2 * CWD + c; u0 = *(const f32x4*)sp; u1 = *(const f32x4*)(sp + CWD);
                float* op = o_cs + (size_t)b * 2 * CWD + c; *(f32x4*)op = u1; *(f32x4*)(op + CWD) = u2; }
            const f32x4 y = bb + u0 * w0 + u1 * w1 + u2 * w2;
            const u32x2 cw = *(const u32x2*)(CB + (size_t)row * CWD + c); f32x4 cb;
            cb[0] = __uint_as_float(cw.x << 16); cb[1] = __uint_as_float(cw.x & 0xffff0000u); cb[2] = __uint_as_float(cw.y << 16); cb[3] = __uint_as_float(cw.y & 0xffff0000u);
            const f32x4 o = cb * y; u32x2 wv; wv.x = cvt_pk_bf16(o[0], o[1]); wv.y = cvt_pk_bf16(o[2], o[3]); *(u32x2*)(V + (size_t)row * CWD + c) = wv;
        }
    }
}

__device__ __forceinline__ void grid_barrier(unsigned* ctr, unsigned target, int wid) {
    asm volatile("s_waitcnt vmcnt(0) lgkmcnt(0)" ::: "memory");
    __builtin_amdgcn_s_barrier();
    if (wid == 0) {
        if (lane_id_v() == 0) {
            __builtin_amdgcn_fence(__ATOMIC_RELEASE, "agent");
            __hip_atomic_fetch_add(ctr, 1u, __ATOMIC_RELAXED, __HIP_MEMORY_SCOPE_AGENT);
            while (__hip_atomic_load(ctr, __ATOMIC_RELAXED, __HIP_MEMORY_SCOPE_AGENT) < target) __builtin_amdgcn_s_sleep(2);
        }
        __builtin_amdgcn_fence(__ATOMIC_ACQUIRE, "agent");
        asm volatile("s_waitcnt vmcnt(0)" ::: "memory");
    }
    __builtin_amdgcn_s_barrier();
    asm volatile("" ::: "memory");
}

constexpr int N_PHASES = 16;
__global__ void __launch_bounds__(NTHREADS, 2) fwd_kernel(Args a) {
    extern __shared__ __attribute__((aligned(16))) unsigned char lds_raw[];
    LAS unsigned char* lds = (LAS unsigned char*)lds_raw;
    const int G = gridDim.x, bx = blockIdx.x, wid = __builtin_amdgcn_readfirstlane(threadIdx.x >> 6);
    unsigned char* ws = a.ws;
    float* mod = (float*)(ws + WS_MOD); bf16_t* H = (bf16_t*)(ws + WS_H); float* XR = (float*)(ws + WS_XR); bf16_t* ACT = (bf16_t*)(ws + WS_R1);
#if ONE_LAUNCH
    cg::this_grid().sync();
#define SEAM(k) do { if ((k) + 1 < a.ph_hi) grid_barrier((unsigned*)(ws + WS_CTL) + (k), (unsigned)G, wid); } while (0)
#else
#define SEAM(k) do { } while (0)
#endif
#define IN(k) (a.ph_lo <= (k) && (k) < a.ph_hi)
#ifdef DBG_STOP
#define DBG_DUMP(k, expr) do { if ((k) == DBG_STOP) { const size_t n_out = (size_t)MR * D + (size_t)NB * 17 * PW + (size_t)NS * 17 * PW; \
        for (size_t i = (size_t)bx * NTHREADS + wid * 64 + lane_id_v(); i < n_out; i += (size_t)G * NTHREADS) a.out[i] = (expr); return; } } while (0)
#else
#define DBG_DUMP(k, expr) do { } while (0)
#endif
    pg8::StaticOrder S;
    if (IN(0)) { p0_prologue(a, lds, G, wid); SEAM(0); }
    if (IN(1)) { pg8::Gemm g{(const bf16_t*)(ws + WS_CS), (const bf16_t*)(ws + WS_R1), D, D, 0}; S.init(1, NMOD / 256, G, bx); EpiMod E{mod, a.in[7]}; pg8::gemm_phase(lds, g, S, E, wid); SEAM(1); DBG_DUMP(1, i < (size_t)256 * NMOD ? mod[i] : 0.f); }
    if (IN(2)) { rowmod_phase(a.in[0], a.in[1], a.in[8], mod, 0, H, G, wid); SEAM(2); }
    if (IN(3)) { pg8::Gemm g{H, (const bf16_t*)(ws + WS_WGU1), D, D, 0}; S.init(NMT, 2 * FF / 256, G, bx); EpiGU E{ACT}; pg8::gemm_phase(lds, g, S, E, wid); SEAM(3); }
    if (IN(4)) { pg8::Gemm g{ACT, (const bf16_t*)(ws + WS_WD1), FF, FF, 0}; S.init(NMT, D / 256, G, bx); EpiRes E{a.in[0], a.in[1], XR, mod + 2 * D, 0.5f}; pg8::gemm_phase(lds, g, S, E, wid); SEAM(4); DBG_DUMP(4, i < (size_t)MR * D ? XR[i] : 0.f); }
    if (IN(5)) { rowmod_phase(XR, XR + (size_t)NP * D, a.in[12], mod, 3, H, G, wid); SEAM(5); }
    if (IN(6)) { pg8::Gemm g{H, (const bf16_t*)(ws + WS_WIN), D, D, 0}; S.init(NMT, INC / 256, G, bx);
        EpiWin E{(float*)(ws + WS_P), (bf16_t*)(ws + WS_CB), (float*)(ws + WS_U), (bf16_t*)(ws + WS_SGA), (bf16_t*)(ws + WS_SGB)}; pg8::gemm_phase(lds, g, S, E, wid); SEAM(6); }
    if (IN(7)) { mixer_phase(a, G, wid); SEAM(7); DBG_DUMP(7, i < (size_t)MR * D ? __uint_as_float((unsigned)((const bf16_t*)(ws + WS_SGA))[i] << 16) : __uint_as_float((unsigned)((const bf16_t*)(ws + WS_SGB))[i - (size_t)MR * D] << 16)); }
    if (IN(8)) { pg8::Gemm g{(const bf16_t*)(ws + WS_AIN), (const bf16_t*)(ws + WS_WGRP), PW, 256, 256}; S.init(NMT, PW / 256, G, bx); EpiGrp E{(bf16_t*)(ws + WS_AP), a.in[15]}; pg8::gemm_phase(lds, g, S, E, wid); SEAM(8); DBG_DUMP(8, i < (size_t)MR * PW ? __uint_as_float((unsigned)((const bf16_t*)(ws + WS_AP))[i] << 16) : (i < (size_t)2 * MR * PW ? __uint_as_float((unsigned)((const bf16_t*)(ws + WS_AIN))[i - (size_t)MR * PW] << 16) : __uint_as_float((unsigned)((const bf16_t*)(ws + WS_V))[i - (size_t)2 * MR * PW] << 16))); }
    if (IN(9)) { pg8::Gemm g{(const bf16_t*)(ws + WS_AP), (const bf16_t*)(ws + WS_WA), PW, PW, 0}; S.init(NMT, D / 256, G, bx); EpiBr<0> E{(const bf16_t*)(ws + WS_SGA), (bf16_t*)(ws + WS_TA), nullptr}; pg8::gemm_phase(lds, g, S, E, wid); SEAM(9); DBG_DUMP(9, i < (size_t)MR * D ? __uint_as_float((unsigned)((const bf16_t*)(ws + WS_TA))[i] << 16) : 0.f); }
    if (IN(10)) { pg8::Gemm g{(const bf16_t*)(ws + WS_V), (const bf16_t*)(ws + WS_WB), CWD, CWD, 0}; S.init(NMT, D / 256, G, bx); EpiBr<1> E{(const bf16_t*)(ws + WS_SGB), (bf16_t*)(ws + WS_TA), H}; pg8::gemm_phase(lds, g, S, E, wid); SEAM(10); }
    if (IN(11)) { pg8::Gemm g{H, (const bf16_t*)(ws + WS_WO), D, D, 0}; S.init(NMT, D / 256, G, bx); EpiRes E{XR, XR + (size_t)NP * D, XR, mod + 5 * D, 1.0f}; pg8::gemm_phase(lds, g, S, E, wid); SEAM(11); DBG_DUMP(11, i < (size_t)MR * D ? XR[i] : 0.f); }
    if (IN(12)) { rowmod_phase(XR, XR + (size_t)NP * D, a.in[21], mod, 6, H, G, wid); SEAM(12); }
    if (IN(13)) { pg8::Gemm g{H, (const bf16_t*)(ws + WS_WGU2), D, D, 0}; S.init(NMT, 2 * FF / 256, G, bx); EpiGU E{ACT}; pg8::gemm_phase(lds, g, S, E, wid); SEAM(13); }
    if (IN(14)) { pg8::Gemm g{ACT, (const bf16_t*)(ws + WS_WD2), FF, FF, 0}; S.init(NMT, D / 256, G, bx); EpiRes E{XR, XR + (size_t)NP * D, XR, mod + 8 * D, 0.5f}; pg8::gemm_phase(lds, g, S, E, wid); SEAM(14); }
    if (IN(15)) { final_norm_phase(XR, a.in[25], a.out, G, wid); }
#undef IN
#undef SEAM
}

extern "C" void kernel_launch(void* const* d_in, const int* in_sizes, int n_in, void* d_out, int out_size, void* d_ws, size_t ws_size, hipStream_t stream) {
    static int grid = 0;
    if (grid == 0) {
        if (n_in != 26 || ws_size < WS_END) { fprintf(stderr, "kernel_launch: unexpected n_in %d / ws %zu (need %zu)\n", n_in, ws_size, (size_t)WS_END); grid = -1; return; }
        int dev = 0, cus = 0, per_cu = 0;
        (void)hipGetDevice(&dev); (void)hipDeviceGetAttribute(&cus, hipDeviceAttributeMultiprocessorCount, dev);
        if (hipFuncSetAttribute((const void*)fwd_kernel, hipFuncAttributeMaxDynamicSharedMemorySize, LDS_BYTES) != hipSuccess) { fprintf(stderr, "kernel_launch: hipFuncSetAttribute failed\n"); grid = -1; return; }
        if (hipOccupancyMaxActiveBlocksPerMultiprocessor(&per_cu, (const void*)fwd_kernel, NTHREADS, LDS_BYTES) != hipSuccess || per_cu < 1) { fprintf(stderr, "kernel_launch: occupancy query gives %d\n", per_cu); per_cu = 1; }
        (void)hipGetLastError();
        grid = cus * 1;
    }
    if (grid < 0) return;
    Args a{};
    for (int i = 0; i < 26; ++i) a.in[i] = (const float*)d_in[i];
    a.out = (float*)d_out; a.ws = (unsigned char*)d_ws;
#if ONE_LAUNCH
    a.ph_lo = 0; a.ph_hi = N_PHASES;
    (void)hipMemsetAsync((unsigned char*)d_ws + WS_CTL, 0, 256, stream);
    void* args[] = {&a};
    hipError_t e = hipLaunchCooperativeKernel((const void*)fwd_kernel, dim3(grid), dim3(NTHREADS), args, LDS_BYTES, stream);
    if (e != hipSuccess) fprintf(stderr, "cooperative launch failed: %s (grid %d)\n", hipGetErrorString(e), grid);
#else
    for (int ph = 0; ph < N_PHASES; ++ph) { a.ph_lo = ph; a.ph_hi = ph + 1; hipLaunchKernelGGL(fwd_kernel, dim3(grid), dim3(NTHREADS), LDS_BYTES, stream, a); }
#endif
}
```

```cpp
#include <hip/hip_runtime.h>
#include <hip/hip_cooperative_groups.h>
#include <cstdio>
#include <cstdint>
#ifndef ONE_LAUNCH
#define ONE_LAUNCH 1
#endif
namespace cg = cooperative_groups;

#define LAS __attribute__((address_space(3)))
typedef unsigned short bf16_t;
typedef short bf16x8 __attribute__((ext_vector_type(8)));
typedef float f32x4 __attribute__((ext_vector_type(4)));
typedef unsigned u32x4 __attribute__((ext_vector_type(4)));
typedef unsigned u32x2 __attribute__((ext_vector_type(2)));

constexpr int D = 2048, FF = 5632, NP = 8192, NS = 128, MR = NP + NS, MP = 8448, NMT = MP / 256;
constexpr int INC = 8192, PW = 1024, CWD = 1024, NMOD = 9 * D, SEQ = 2048, NB = 4;
constexpr float EPS = 1e-6f;
constexpr int NTHREADS = 512;
constexpr int LDS_BYTES = 131072;

constexpr size_t al256(size_t x) { return (x + 255) & ~(size_t)255; }
constexpr size_t WS_WGU1 = 0;
constexpr size_t WS_WD1 = WS_WGU1 + (size_t)2 * FF * D * 2;
constexpr size_t WS_WIN = WS_WD1 + (size_t)D * FF * 2;
constexpr size_t WS_WGRP = WS_WIN + (size_t)INC * D * 2;
constexpr size_t WS_WA = WS_WGRP + (size_t)PW * 256 * 2;
constexpr size_t WS_WB = WS_WA + (size_t)D * PW * 2;
constexpr size_t WS_WO = WS_WB + (size_t)D * CWD * 2;
constexpr size_t WS_WGU2 = WS_WO + (size_t)D * D * 2;
constexpr size_t WS_WD2 = WS_WGU2 + (size_t)2 * FF * D * 2;
constexpr size_t WS_MOD = WS_WD2 + (size_t)D * FF * 2;
constexpr size_t WS_CS = WS_MOD + (size_t)256 * NMOD * 4;
constexpr size_t WS_H = WS_CS + (size_t)256 * D * 2;
constexpr size_t WS_XR = WS_H + (size_t)MP * D * 2;
constexpr size_t WS_R1 = WS_XR + (size_t)MP * D * 4;
constexpr size_t R1_BYTES = (size_t)MP * FF * 2;
constexpr size_t WS_P = WS_R1;
constexpr size_t WS_U = WS_P + (size_t)MP * PW * 4;
constexpr size_t WS_CB = WS_U + (size_t)MP * CWD * 4;
static_assert(WS_CB + (size_t)MP * CWD * 2 <= WS_R1 + R1_BYTES, "R1 overlay");
static_assert((size_t)NMOD * D * 2 <= R1_BYTES, "Wada overlay");
constexpr size_t WS_SGA = WS_R1 + R1_BYTES;
constexpr size_t WS_SGB = WS_SGA + (size_t)MP * D * 2;
constexpr size_t WS_AIN = WS_SGB + (size_t)MP * D * 2;
constexpr size_t WS_AP = WS_AIN + (size_t)MP * PW * 2;
constexpr size_t WS_V = WS_AP + (size_t)MP * PW * 2;
constexpr size_t WS_TA = WS_V + (size_t)MP * CWD * 2;
constexpr size_t WS_CTL = WS_TA + (size_t)MP * D * 2;
constexpr size_t WS_END = WS_CTL + 256;

typedef float f32x2_t __attribute__((ext_vector_type(2)));
typedef __bf16 bf16x2_t __attribute__((ext_vector_type(2)));
__device__ __forceinline__ unsigned cvt_pk_bf16(float lo, float hi) { const f32x2_t v = {lo, hi}; const bf16x2_t b = __builtin_convertvector(v, bf16x2_t); return __builtin_bit_cast(unsigned, b); }
__device__ __forceinline__ u32x4 pack8(f32x4 a, f32x4 b) { u32x4 w; w.x = cvt_pk_bf16(a[0], a[1]); w.y = cvt_pk_bf16(a[2], a[3]); w.z = cvt_pk_bf16(b[0], b[1]); w.w = cvt_pk_bf16(b[2], b[3]); return w; }
__device__ __forceinline__ void unpack8(u32x4 w, f32x4& a, f32x4& b) {
    a[0] = __uint_as_float(w.x << 16); a[1] = __uint_as_float(w.x & 0xffff0000u); a[2] = __uint_as_float(w.y << 16); a[3] = __uint_as_float(w.y & 0xffff0000u);
    b[0] = __uint_as_float(w.z << 16); b[1] = __uint_as_float(w.z & 0xffff0000u); b[2] = __uint_as_float(w.w << 16); b[3] = __uint_as_float(w.w & 0xffff0000u); }
__device__ __forceinline__ float sigm_f(float x) { return __builtin_amdgcn_rcpf(1.0f + __expf(-x)); }
__device__ __forceinline__ float silu_f(float x) { return x * sigm_f(x); }
__device__ __forceinline__ int lane_id_v() { int l; asm volatile("v_mbcnt_lo_u32_b32 %0, -1, 0\n\tv_mbcnt_hi_u32_b32 %0, -1, %0" : "=v"(l)); return l; }
__device__ __forceinline__ int bidx(int row) { return row < NP ? (row >> 11) : (row - NP + NB); }

namespace pg8 {
constexpr int BM = 256, BK = 64, HALF = 128, HTB = HALF * BK * 2, STAGE_BYTES = 8 * HTB, NXCD = 8, WGM = 8;
__host__ __device__ __forceinline__ int lds_byte(int r, int c) { const int st = (r >> 4) * 2 + (c >> 5), rr = r & 15, cc = c & 31, ob = rr * 64 + cc * 2; return st * 1024 + (ob ^ (((ob >> 9) & 1) << 5)); }
__host__ __device__ __forceinline__ void stage_rc(int b, int& R, int& C) { const int st = b / 1024, sb = b % 1024, swz = sb ^ (((sb >> 9) & 1) << 5); R = (st >> 1) * 16 + swz / 64; C = (st & 1) * 32 + (swz % 64) / 2; }
__host__ __device__ __forceinline__ int perm32(int rho) { const int n = rho >> 4, i = rho & 15; return 8 * (i >> 2) + 4 * n + (i & 3); }

struct Unit { int pm, pn; };
struct Gemm { const bf16_t* A; const bf16_t* Bt; int lda, K, a_pn_off; };

struct StaticOrder {
    int nM, nN, nwg, G, c;
    __device__ void init(int nM_, int nN_, int G_, int c_) { nM = nM_; nN = nN_; nwg = nM * nN; G = G_; c = c_; }
    __device__ bool next(int i, Unit& u) const {
        const long L = (long)i * G + c; if (L >= nwg) return false;
        int wgid = (int)L; { const int q = nwg / NXCD, r = nwg % NXCD, xcd = wgid % NXCD, off = wgid / NXCD; wgid = (xcd < r ? xcd * (q + 1) : r * (q + 1) + (xcd - r) * q) + off; }
        const int nig = WGM * nN, gid = wgid / nig, fm = gid * WGM, gsz = (nM - fm) < WGM ? (nM - fm) : WGM;
        u.pm = fm + ((wgid % nig) % gsz); u.pn = (wgid % nig) / gsz; return true;
    }
};

template <class Epi>
__device__ __forceinline__ void gemm_phase(LAS unsigned char* lds, const Gemm g, const StaticOrder& S, const Epi& E, const int wid) {
    const int lane = lane_id_v(), tid = wid * 64 + lane, wr = wid >> 2, wc = wid & 3, fr = lane & 15, fq = lane >> 4;
    const int K = g.K, nt = K / BK, lda = g.lda;
    unsigned voffA[2], voffB[2];
#pragma unroll
    for (int i = 0; i < 2; ++i) { int R, C; stage_rc(tid * 16 + i * 8192, R, C); const int Rb = (R & ~31) + perm32(R & 31);
        voffA[i] = (unsigned)(R * lda + C) * 2u; voffB[i] = (unsigned)(Rb * K + C) * 2u; }
    const size_t kstep = (size_t)(BK * 2);
    const size_t hstepA = (size_t)HALF * lda * 2, tstepA = 2 * hstepA;
    const size_t hstepB = (size_t)HALF * K * 2, tstepB = 2 * hstepB;
    const size_t pnA = (size_t)g.a_pn_off * 2;
    const unsigned ldsw = (unsigned)wid * 1024u;
    const int aoff = lds_byte(wr * 64 + fr, fq * 8), boff = lds_byte(wc * 32 + fr, fq * 8);
#define PG8_SA(b, h) (((b) * 2 + (h)) * HTB)
#define PG8_SB(b, h) ((4 + (b) * 2 + (h)) * HTB)
#define PG8_STAGE(bufoff, gbase, voff) do { _Pragma("unroll") for (int _i = 0; _i < 2; ++_i) \
        __builtin_amdgcn_global_load_lds((const unsigned*)((const char*)(gbase) + (voff)[_i]), (LAS unsigned*)(lds + (bufoff) + ldsw + _i * 8192), 16, 0, 0); } while (0)
#define PG8_LDA(dst, b, h) do { _Pragma("unroll") for (int m = 0; m < 4; ++m) _Pragma("unroll") for (int k = 0; k < 2; ++k) dst[m][k] = *(const LAS bf16x8*)(lds + PG8_SA(b, h) + aoff + m * 2048 + k * 1024); } while (0)
#define PG8_LDB(dst, b, h) do { _Pragma("unroll") for (int n = 0; n < 2; ++n) _Pragma("unroll") for (int k = 0; k < 2; ++k) dst[n][k] = *(const LAS bf16x8*)(lds + PG8_SB(b, h) + boff + n * 2048 + k * 1024); } while (0)
#define PG8_MMA(ai, bj, At, Bt) do { __builtin_amdgcn_s_setprio(1); _Pragma("unroll") for (int m = 0; m < 4; ++m) _Pragma("unroll") for (int n = 0; n < 2; ++n) _Pragma("unroll") for (int k = 0; k < 2; ++k) \
        acc[ai][bj][m][n] = __builtin_amdgcn_mfma_f32_16x16x32_bf16(Bt[n][k], At[m][k], acc[ai][bj][m][n], 0, 0, 0); __builtin_amdgcn_s_setprio(0); } while (0)
#define PG8_WAIT_V(n) asm volatile("s_waitcnt vmcnt(" #n ")" ::: "memory")
#define PG8_WAIT_L(n) asm volatile("s_waitcnt lgkmcnt(" #n ")" ::: "memory")
#define PG8_BAR __builtin_amdgcn_s_barrier()
#define PG8_SCHED __builtin_amdgcn_sched_barrier(0)
    Unit cur, nxt; int ui = 0;
    if (!S.next(0, cur)) return;
    f32x4 acc[2][2][4][2];
#pragma unroll
    for (int a = 0; a < 2; ++a)
#pragma unroll
        for (int b = 0; b < 2; ++b)
#pragma unroll
            for (int m = 0; m < 4; ++m)
#pragma unroll
                for (int n = 0; n < 2; ++n) acc[a][b][m][n] = (f32x4){0.f, 0.f, 0.f, 0.f};
    bf16x8 At[4][2], B0[2][2], B1[2][2];
    const char* cA = (const char*)g.A + (size_t)cur.pm * tstepA + (size_t)cur.pn * pnA; const char* cB = (const char*)g.Bt + (size_t)cur.pn * tstepB;
    PG8_STAGE(PG8_SB(0, 0), cB, voffB); PG8_STAGE(PG8_SB(0, 1), cB + hstepB, voffB); PG8_STAGE(PG8_SA(0, 0), cA, voffA); PG8_STAGE(PG8_SA(0, 1), cA + hstepA, voffA);
    if (wr == 1) PG8_BAR;
    PG8_WAIT_V(2); PG8_BAR;
    PG8_STAGE(PG8_SB(1, 0), cB + kstep, voffB); PG8_STAGE(PG8_SA(1, 0), cA + kstep, voffA); PG8_STAGE(PG8_SB(1, 1), cB + hstepB + kstep, voffB);
    PG8_WAIT_V(6); PG8_BAR;
    for (;;) {
        const bool has_next = S.next(ui + 1, nxt);
        const char* nA = has_next ? (const char*)g.A + (size_t)nxt.pm * tstepA + (size_t)nxt.pn * pnA : cA; const char* nB = has_next ? (const char*)g.Bt + (size_t)nxt.pn * tstepB : cB;
#pragma clang loop unroll(disable)
        for (int t = 0; t < nt; t += 2) {
            const bool last = (t == nt - 2);
            const char* a1 = cA + (size_t)(t + 1) * kstep;
            const char* a2 = last ? nA : cA + (size_t)(t + 2) * kstep; const char* b2 = last ? nB : cB + (size_t)(t + 2) * kstep;
            const char* a3 = a2 + kstep; const char* b3 = b2 + kstep;
            PG8_LDB(B0, 0, 0); PG8_LDB(B1, 0, 1); PG8_SCHED; PG8_LDA(At, 0, 0); PG8_STAGE(PG8_SA(1, 1), a1 + hstepA, voffA);
            PG8_WAIT_V(8); PG8_WAIT_L(0); PG8_BAR; PG8_MMA(0, 0, At, B0); PG8_MMA(0, 1, At, B1); PG8_BAR; PG8_SCHED;
            PG8_LDA(At, 0, 1); PG8_STAGE(PG8_SB(0, 0), b2, voffB); PG8_STAGE(PG8_SB(0, 1), b2 + hstepB, voffB); PG8_STAGE(PG8_SA(0, 0), a2, voffA);
            PG8_WAIT_V(8); PG8_WAIT_L(0); PG8_BAR; PG8_MMA(1, 0, At, B0); PG8_MMA(1, 1, At, B1); PG8_BAR; PG8_SCHED;
            PG8_LDB(B0, 1, 0); PG8_LDB(B1, 1, 1); PG8_SCHED; PG8_LDA(At, 1, 0); PG8_STAGE(PG8_SA(0, 1), a2 + hstepA, voffA);
            PG8_WAIT_V(8); PG8_WAIT_L(0); PG8_BAR; PG8_MMA(0, 0, At, B0); PG8_MMA(0, 1, At, B1); PG8_BAR; PG8_SCHED;
            PG8_LDA(At, 1, 1); PG8_STAGE(PG8_SB(1, 0), b3, voffB); PG8_STAGE(PG8_SB(1, 1), b3 + hstepB, voffB); PG8_STAGE(PG8_SA(1, 0), a3, voffA);
            PG8_WAIT_V(8); PG8_WAIT_L(0); PG8_BAR; PG8_MMA(1, 0, At, B0); PG8_MMA(1, 1, At, B1); PG8_BAR; PG8_SCHED;
        }
        if (wr == 0) PG8_BAR;
        { const int el = lane_id_v(); E(acc, cur, wr, wc, el & 15, el >> 4); }
        if (!has_next) break;
#pragma unroll
        for (int a = 0; a < 2; ++a)
#pragma unroll
            for (int b = 0; b < 2; ++b)
#pragma unroll
                for (int m = 0; m < 4; ++m)
#pragma unroll
                    for (int n = 0; n < 2; ++n) acc[a][b][m][n] = (f32x4){0.f, 0.f, 0.f, 0.f};
        cur = nxt; cA = nA; cB = nB; ++ui;
        if (wr == 1) PG8_BAR;
    }
    PG8_WAIT_V(0);
    PG8_BAR;
#undef PG8_SA
#undef PG8_SB
#undef PG8_STAGE
#undef PG8_LDA
#undef PG8_LDB
#undef PG8_MMA
#undef PG8_WAIT_V
#undef PG8_WAIT_L
#undef PG8_BAR
#undef PG8_SCHED
}
}

using pg8::Unit;
typedef f32x4 AccT[2][2][4][2];
#define EPI_ROW(u, ai, m) ((u).pm * 256 + (ai) * 128 + wr * 64 + (m) * 16 + fr)
#define EPI_COL(u, bj) ((u).pn * 256 + (bj) * 128 + wc * 32 + fq * 8)

struct EpiMod {
    float* mod; const float* bias;
    __device__ __forceinline__ void operator()(const AccT& acc, const Unit& u, int wr, int wc, int fr, int fq) const {
#pragma unroll
        for (int bj = 0; bj < 2; ++bj) { const int col = EPI_COL(u, bj); const f32x4 b0 = *(const f32x4*)(bias + col), b1 = *(const f32x4*)(bias + col + 4);
#pragma unroll
            for (int ai = 0; ai < 2; ++ai)
#pragma unroll
                for (int m = 0; m < 4; ++m) { float* p = mod + (size_t)EPI_ROW(u, ai, m) * NMOD + col; *(f32x4*)p = acc[ai][bj][m][0] + b0; *(f32x4*)(p + 4) = acc[ai][bj][m][1] + b1; } }
    }
};
struct EpiGU {
    bf16_t* act;
    __device__ __forceinline__ void operator()(const AccT& acc, const Unit& u, int wr, int wc, int fr, int fq) const {
#pragma unroll
        for (int ai = 0; ai < 2; ++ai)
#pragma unroll
            for (int m = 0; m < 4; ++m) { f32x4 o[2];
#pragma unroll
                for (int n = 0; n < 2; ++n)
#pragma unroll
                    for (int j = 0; j < 4; ++j) o[n][j] = silu_f(acc[ai][0][m][n][j]) * acc[ai][1][m][n][j];
                *(u32x4*)(act + (size_t)EPI_ROW(u, ai, m) * FF + u.pn * 128 + wc * 32 + fq * 8) = pack8(o[0], o[1]); }
    }
};
struct EpiRes {
    const float* baseP; const float* baseS; float* out; const float* gate; float gs;
    __device__ __forceinline__ void operator()(const AccT& acc, const Unit& u, int wr, int wc, int fr, int fq) const {
#pragma unroll
        for (int ai = 0; ai < 2; ++ai)
#pragma unroll
            for (int m = 0; m < 4; ++m) { const int row = EPI_ROW(u, ai, m);
                if (row < MR) { const float* bp = row < NP ? baseP + (size_t)row * D : baseS + (size_t)(row - NP) * D; const float* gp = gate + (size_t)bidx(row) * NMOD; float* op = out + (size_t)row * D;
#pragma unroll
                    for (int bj = 0; bj < 2; ++bj) { const int col = EPI_COL(u, bj);
#pragma unroll
                        for (int n = 0; n < 2; ++n) { const f32x4 b = *(const f32x4*)(bp + col + 4 * n), gg = *(const f32x4*)(gp + col + 4 * n); *(f32x4*)(op + col + 4 * n) = b + gs * gg * acc[ai][bj][m][n]; } } }
                asm volatile("" ::: "memory"); }
    }
};
struct EpiWin {
    float* P; bf16_t* CB; float* U; bf16_t* SGA; bf16_t* SGB;
    __device__ __forceinline__ void operator()(const AccT& acc, const Unit& u, int wr, int wc, int fr, int fq) const {
        const int pn = u.pn;
        if (pn < 4) {
#pragma unroll
            for (int ai = 0; ai < 2; ++ai)
#pragma unroll
                for (int m = 0; m < 4; ++m) { float* p = P + (size_t)EPI_ROW(u, ai, m) * PW;
#pragma unroll
                    for (int bj = 0; bj < 2; ++bj) { const int col = EPI_COL(u, bj); *(f32x4*)(p + col) = acc[ai][bj][m][0]; *(f32x4*)(p + col + 4) = acc[ai][bj][m][1]; } }
        } else if (pn < 8) {
#pragma unroll
            for (int ai = 0; ai < 2; ++ai)
#pragma unroll
                for (int m = 0; m < 4; ++m) { bf16_t* p = CB + (size_t)EPI_ROW(u, ai, m) * CWD - 1024;
#pragma unroll
                    for (int bj = 0; bj < 2; ++bj) *(u32x4*)(p + EPI_COL(u, bj)) = pack8(acc[ai][bj][m][0], acc[ai][bj][m][1]); }
        } else if (pn < 16) {
#pragma unroll
            for (int ai = 0; ai < 2; ++ai)
#pragma unroll
                for (int m = 0; m < 4; ++m) { float* p = U + (size_t)EPI_ROW(u, ai, m) * CWD + (pn - 8) * 128 + wc * 32 + fq * 8;
                    *(f32x4*)p = acc[ai][0][m][0] * acc[ai][1][m][0]; *(f32x4*)(p + 4) = acc[ai][0][m][1] * acc[ai][1][m][1]; }
        } else {
            bf16_t* base = pn < 24 ? SGA - 4096 : SGB - 6144;
#pragma unroll
            for (int ai = 0; ai < 2; ++ai)
#pragma unroll
                for (int m = 0; m < 4; ++m) { bf16_t* p = base + (size_t)EPI_ROW(u, ai, m) * D;
#pragma unroll
                    for (int bj = 0; bj < 2; ++bj) { f32x4 o[2];
#pragma unroll
                        for (int n = 0; n < 2; ++n)
#pragma unroll
                            for (int j = 0; j < 4; ++j) o[n][j] = sigm_f(acc[ai][bj][m][n][j]);
                        *(u32x4*)(p + EPI_COL(u, bj)) = pack8(o[0], o[1]); } }
        }
    }
};
struct EpiGrp {
    bf16_t* AP; const float* scale; int coff;
    __device__ __forceinline__ void operator()(const AccT& acc, const Unit& u, int wr, int wc, int fr, int fq) const {
#pragma unroll
        for (int bj = 0; bj < 2; ++bj) { const int col = coff + EPI_COL(u, bj); const f32x4 s0 = *(const f32x4*)(scale + col), s1 = *(const f32x4*)(scale + col + 4);
#pragma unroll
            for (int ai = 0; ai < 2; ++ai)
#pragma unroll
                for (int m = 0; m < 4; ++m) *(u32x4*)(AP + (size_t)EPI_ROW(u, ai, m) * PW + col) = pack8(acc[ai][bj][m][0] * s0, acc[ai][bj][m][1] * s1); }
    }
};
template <int MODE> struct EpiBr {
    const bf16_t* SG; bf16_t* TA; bf16_t* MO;
    __device__ __forceinline__ void operator()(const AccT& acc, const Unit& u, int wr, int wc, int fr, int fq) const {
#pragma unroll
        for (int ai = 0; ai < 2; ++ai)
#pragma unroll
            for (int m = 0; m < 4; ++m) { const size_t ro = (size_t)EPI_ROW(u, ai, m) * D;
#pragma unroll
                for (int bj = 0; bj < 2; ++bj) { const size_t o = ro + EPI_COL(u, bj); f32x4 s0, s1; unpack8(*(const u32x4*)(SG + o), s0, s1);
                    f32x4 r0 = s0 * acc[ai][bj][m][0], r1 = s1 * acc[ai][bj][m][1];
                    if (MODE == 1) { f32x4 t0, t1; unpack8(*(const u32x4*)(TA + o), t0, t1); r0 += t0; r1 += t1; *(u32x4*)(MO + o) = pack8(r0, r1); }
                    else *(u32x4*)(TA + o) = pack8(r0, r1); }
                asm volatile("" ::: "memory"); }
    }
};

struct Args { const float* in[26]; float* out; unsigned char* ws; int ph_lo, ph_hi; };

__device__ __forceinline__ int map_row(int map, int n) {
    if (map == 1) return (n >> 7) * 256 + (n & 127);
    if (map == 2) return (n >> 7) * 256 + 128 + (n & 127);
    if (map == 3) { if (n < 2048 || n >= 4096) return n; if (n < 3072) { const int j = n - 2048; return 2048 + (j >> 7) * 256 + (j & 127); } const int j = n - 3072; return 2048 + (j >> 7) * 256 + 128 + (j & 127); }
    return n;
}
__device__ void cvt_task(LAS unsigned* T0, const float* src, bf16_t* dst, int K, int N, int dstK, int map, int& base, int G, int tid, int& par) {
    const int tn = N / 64, ntiles = (K / 128) * tn;
    const int nq = tid & 15, kp = tid >> 4;
    const int first = ((int)blockIdx.x - base % G + G) % G;
    base += ntiles;
    if (first >= ntiles) return;
    f32x4 r[2][2], rn[2][2];
    { const int kt = first / tn, ntile = first - kt * tn, k0 = kt * 128, n0 = ntile * 64;
#pragma unroll
      for (int it = 0; it < 2; ++it) { const int k = k0 + 2 * (kp + 32 * it); r[it][0] = *(const f32x4*)(src + (size_t)k * N + n0 + nq * 4); r[it][1] = *(const f32x4*)(src + (size_t)(k + 1) * N + n0 + nq * 4); } }
    for (int t = first; t < ntiles; t += G) {
        const int kt = t / tn, ntile = t - kt * tn, k0 = kt * 128, n0 = ntile * 64;
        const int t2 = t + G;
        if (t2 < ntiles) { const int kt2 = t2 / tn, ntile2 = t2 - kt2 * tn, k02 = kt2 * 128, n02 = ntile2 * 64;
#pragma unroll
            for (int it = 0; it < 2; ++it) { const int k = k02 + 2 * (kp + 32 * it); rn[it][0] = *(const f32x4*)(src + (size_t)k * N + n02 + nq * 4); rn[it][1] = *(const f32x4*)(src + (size_t)(k + 1) * N + n02 + nq * 4); } }
        LAS unsigned* T = T0 + par * (64 * 65); par ^= 1;
#pragma unroll
        for (int it = 0; it < 2; ++it) { const int kk = kp + 32 * it;
#pragma unroll
            for (int j = 0; j < 4; ++j) T[(nq * 4 + j) * 65 + kk] = cvt_pk_bf16(r[it][0][j], r[it][1][j]); }
        __syncthreads();
        const int n0d = map_row(map, n0);
#pragma unroll
        for (int ps = 0; ps < 2; ++ps) { const int nl = (tid >> 4) + 32 * ps, kq = tid & 15; u32x4 w;
            w.x = T[nl * 65 + kq * 4 + 0]; w.y = T[nl * 65 + kq * 4 + 1]; w.z = T[nl * 65 + kq * 4 + 2]; w.w = T[nl * 65 + kq * 4 + 3];
            *(u32x4*)(dst + (size_t)(n0d + nl) * dstK + k0 + kq * 8) = w; }
#pragma unroll
        for (int it = 0; it < 2; ++it) { r[it][0] = rn[it][0]; r[it][1] = rn[it][1]; }
    }
}

__device__ void p0_prologue(const Args& a, LAS unsigned char* lds, int G, int wid) {
    const int tid = wid * 64 + lane_id_v();
    unsigned char* ws = a.ws; LAS unsigned* T = (LAS unsigned*)lds; int base = 0, par = 0;
    cvt_task(T, a.in[6], (bf16_t*)(ws + WS_R1), D, NMOD, D, 0, base, G, tid, par);
    cvt_task(T, a.in[9], (bf16_t*)(ws + WS_WGU1), D, FF, D, 1, base, G, tid, par);
    cvt_task(T, a.in[10], (bf16_t*)(ws + WS_WGU1), D, FF, D, 2, base, G, tid, par);
    cvt_task(T, a.in[11], (bf16_t*)(ws + WS_WD1), FF, D, FF, 0, base, G, tid, par);
    cvt_task(T, a.in[13], (bf16_t*)(ws + WS_WIN), D, INC, D, 3, base, G, tid, par);
    for (int g = 0; g < 4; ++g) cvt_task(T, a.in[14] + (size_t)g * 65536, (bf16_t*)(ws + WS_WGRP) + (size_t)g * 65536, 256, 256, 256, 0, base, G, tid, par);
    cvt_task(T, a.in[16], (bf16_t*)(ws + WS_WA), PW, D, PW, 0, base, G, tid, par);
    cvt_task(T, a.in[19], (bf16_t*)(ws + WS_WB), CWD, D, CWD, 0, base, G, tid, par);
    cvt_task(T, a.in[20], (bf16_t*)(ws + WS_WO), D, D, D, 0, base, G, tid, par);
    cvt_task(T, a.in[22], (bf16_t*)(ws + WS_WGU2), D, FF, D, 1, base, G, tid, par);
    cvt_task(T, a.in[23], (bf16_t*)(ws + WS_WGU2), D, FF, D, 2, base, G, tid, par);
    cvt_task(T, a.in[24], (bf16_t*)(ws + WS_WD2), FF, D, FF, 0, base, G, tid, par);
    bf16_t* cs = (bf16_t*)(ws + WS_CS);
    for (int i = blockIdx.x * NTHREADS + tid; i < 256 * D / 4; i += G * NTHREADS) { const int row = i / (D / 4), c4 = (i - row * (D / 4)) * 4; u32x2 w = {0u, 0u};
        if (row < NB + NS) { const float* cp = row < NB ? a.in[2] + (size_t)row * D : a.in[3] + (size_t)(row - NB) * D; const f32x4 v = *(const f32x4*)(cp + c4);
            w.x = cvt_pk_bf16(silu_f(v[0]), silu_f(v[1])); w.y = cvt_pk_bf16(silu_f(v[2]), silu_f(v[3])); }
        *(u32x2*)(cs + (size_t)row * D + c4) = w; }
}

__device__ __forceinline__ float wave_sum(float s) {
#pragma unroll
    for (int o = 32; o >= 1; o >>= 1) s += __shfl_xor(s, o);
    return s;
}
__device__ void rowmod_phase(const float* srcP, const float* srcS, const float* normw, const float* mod, int jsh, bf16_t* h, int G, int wid) {
    const int lane = lane_id_v();
    for (int row = blockIdx.x * 8 + wid; row < MR; row += G * 8) {
        const float* src = row < NP ? srcP + (size_t)row * D : srcS + (size_t)(row - NP) * D;
        const float* sh = mod + (size_t)bidx(row) * NMOD + (size_t)jsh * D; const float* sc = sh + D;
        f32x4 v[8]; float ss = 0.f;
#pragma unroll
        for (int i = 0; i < 8; ++i) { v[i] = *(const f32x4*)(src + (i * 64 + lane) * 4); ss += v[i][0] * v[i][0] + v[i][1] * v[i][1] + v[i][2] * v[i][2] + v[i][3] * v[i][3]; }
        ss = wave_sum(ss); const float inv = rsqrtf(ss * (1.0f / D) + EPS);
#pragma unroll
        for (int i = 0; i < 8; ++i) { const int c = (i * 64 + lane) * 4; const f32x4 g4 = *(const f32x4*)(normw + c), s4 = *(const f32x4*)(sc + c), h4 = *(const f32x4*)(sh + c);
            const f32x4 o = (v[i] * inv) * g4 * (1.0f + s4) + h4; u32x2 w; w.x = cvt_pk_bf16(o[0], o[1]); w.y = cvt_pk_bf16(o[2], o[3]); *(u32x2*)(h + (size_t)row * D + c) = w; }
    }
}
__device__ void final_norm_phase(const float* xr, const float* normw, float* out, int G, int wid) {
    const int lane = lane_id_v();
    for (int row = blockIdx.x * 8 + wid; row < MR; row += G * 8) {
        const float* src = xr + (size_t)row * D; f32x4 v[8]; float ss = 0.f;
#pragma unroll
        for (int i = 0; i < 8; ++i) { v[i] = *(const f32x4*)(src + (i * 64 + lane) * 4); ss += v[i][0] * v[i][0] + v[i][1] * v[i][1] + v[i][2] * v[i][2] + v[i][3] * v[i][3]; }
        ss = wave_sum(ss); const float inv = rsqrtf(ss * (1.0f / D) + EPS);
#pragma unroll
        for (int i = 0; i < 8; ++i) { const int c = (i * 64 + lane) * 4; *(f32x4*)(out + (size_t)row * D + c) = (v[i] * inv) * *(const f32x4*)(normw + c); }
    }
}
__device__ void mixer_phase(const Args& a, int G, int wid) {
    unsigned char* ws = a.ws;
    const float* P = (const float*)(ws + WS_P); const float* U = (const float*)(ws + WS_U); const bf16_t* CB = (const bf16_t*)(ws + WS_CB);
    bf16_t* AIN = (bf16_t*)(ws + WS_AIN); bf16_t* V = (bf16_t*)(ws + WS_V);
    const float* state_pool = a.in[4]; const float* state_conv = a.in[5]; const float* conv_w = a.in[17]; const float* conv_b = a.in[18];
    float* o_pp = a.out + (size_t)MR * D; float* o_cp = o_pp + (size_t)NB * 15 * PW; float* o_cs; float* o_ps = o_cp + (size_t)NB * 2 * CWD; o_cs = o_ps + (size_t)NS * 15 * PW;
    const int tid = wid * 64 + lane_id_v();
    const f32x4 z4 = {0.f, 0.f, 0.f, 0.f};
    if (wid < 4) {
        const int c = tid * 4, g = tid >> 6, w = 2 << g;
        for (int ch = blockIdx.x; ch < NP / 32; ch += G) {
            const int r0 = ch * 32, b = r0 >> 11, t0 = r0 & (SEQ - 1);
            f32x4 s = z4;
            for (int i = 1; i < w; ++i) if (t0 - i >= 0) s += *(const f32x4*)(P + (size_t)(r0 - i) * PW + c);
#pragma unroll 4
            for (int j = 0; j < 32; ++j) { const int row = r0 + j, t = t0 + j;
                const f32x4 pc = *(const f32x4*)(P + (size_t)row * PW + c);
                f32x4 old = z4; if (t - (w - 1) >= 0) old = *(const f32x4*)(P + (size_t)(row - (w - 1)) * PW + c);
                s += pc; const int cnt = (t + 1) < w ? (t + 1) : w;
                const f32x4 o = s * (1.0f / (float)cnt) - pc; u32x2 wv; wv.x = cvt_pk_bf16(o[0], o[1]); wv.y = cvt_pk_bf16(o[2], o[3]); *(u32x2*)(AIN + (size_t)row * PW + c) = wv;
                if (t >= SEQ - 15) *(f32x4*)(o_pp + ((size_t)b * 15 + (t - (SEQ - 15))) * PW + c) = pc;
                s -= old; }
        }
        for (int b = blockIdx.x; b < NS; b += G) { const int row = NP + b;
            const f32x4 pc = *(const f32x4*)(P + (size_t)row * PW + c); f32x4 s = pc; const float* sp = state_pool + (size_t)b * 15 * PW + c;
            for (int i = 1; i < w; ++i) s += *(const f32x4*)(sp + (size_t)(15 - i) * PW);
            float* op = o_ps + (size_t)b * 15 * PW + c;
#pragma unroll
            for (int i = 0; i < 14; ++i) *(f32x4*)(op + (size_t)i * PW) = *(const f32x4*)(sp + (size_t)(i + 1) * PW);
            *(f32x4*)(op + (size_t)14 * PW) = pc;
            const f32x4 o = s * (1.0f / (float)w) - pc; u32x2 wv; wv.x = cvt_pk_bf16(o[0], o[1]); wv.y = cvt_pk_bf16(o[2], o[3]); *(u32x2*)(AIN + (size_t)row * PW + c) = wv; }
    } else {
        const int c = (tid - 256) * 4;
        const f32x4 w0 = *(const f32x4*)(conv_w + c), w1 = *(const f32x4*)(conv_w + CWD + c), w2 = *(const f32x4*)(conv_w + 2 * CWD + c), bb = *(const f32x4*)(conv_b + c);
        for (int ch = blockIdx.x; ch < NP / 32; ch += G) {
            const int r0 = ch * 32, b = r0 >> 11, t0 = r0 & (SEQ - 1);
            f32x4 u0 = z4, u1 = z4;
            if (t0 > 0) { u0 = *(const f32x4*)(U + (size_t)(r0 - 2) * CWD + c); u1 = *(const f32x4*)(U + (size_t)(r0 - 1) * CWD + c); }
#pragma unroll 4
            for (int j = 0; j < 32; ++j) { const int row = r0 + j, t = t0 + j;
                const f32x4 u2 = *(const f32x4*)(U + (size_t)row * CWD + c);
                const u32x2 cw = *(const u32x2*)(CB + (size_t)row * CWD + c); f32x4 cb;
                cb[0] = __uint_as_float(cw.x << 16); cb[1] = __uint_as_float(cw.x & 0xffff0000u); cb[2] = __uint_as_float(cw.y << 16); cb[3] = __uint_as_float(cw.y & 0xffff0000u);
                const f32x4 y = bb + u0 * w0 + u1 * w1 + u2 * w2;
                const f32x4 o = cb * y; u32x2 wv; wv.x = cvt_pk_bf16(o[0], o[1]); wv.y = cvt_pk_bf16(o[2], o[3]); *(u32x2*)(V + (size_t)row * CWD + c) = wv;
                if (t >= SEQ - 2) *(f32x4*)(o_cp + ((size_t)b * 2 + (t - (SEQ - 2))) * CWD + c) = u2;
                u0 = u1; u1 = u2; }
        }
        for (int b = blockIdx.x; b < NS; b += G) { const int row = NP + b;
            const f32x4 u2 = *(const f32x4*)(U + (size_t)row * CWD + c); const float* sp = state_conv + (size_t)b * 2 * CWD + c; const f32x4 u0 = *(const f32x4*)sp, u1 = *(const f32x4*)(sp + CWD);
            float* op = o_cs + (size_t)b * 2 * CWD + c; *(f32x4*)op = u1; *(f32x4*)(op + CWD) = u2;
            const u32x2 cw = *(const u32x2*)(CB + (size_t)row * CWD + c); f32x4 cb;
            cb[0] = __uint_as_float(cw.x << 16); cb[1] = __uint_as_float(cw.x & 0xffff0000u); cb[2] = __uint_as_float(cw.y << 16); cb[3] = __uint_as_float(cw.y & 0xffff0000u);
            const f32x4 y = bb + u0 * w0 + u1 * w1 + u2 * w2;
            const f32x4 o = cb * y; u32x2 wv; wv.x = cvt_pk_bf16(o[0], o[1]); wv.y = cvt_pk_bf16(o[2], o[3]); *(u32x2*)(V + (size_t)row * CWD + c) = wv; }
    }
}

template <int NBF, class Epi>
__device__ __forceinline__ void skinny_phase(LAS unsigned char* lds, const bf16_t* As, int lda, const bf16_t* Bt, int K, int n_nt, int tsh, int gsh, int foff,
                                             const Epi& E, int bx, int blk_lo, int blk_n, int wid) {
    const int rel = bx - blk_lo; if (rel < 0 || rel >= blk_n) return;
    const int lane = lane_id_v(), fr = lane & 15, fq = lane >> 4;
    const int KS = K >> 3, k_lo = wid * KS, n_units = n_nt * 2;
    LAS f32x4* red = (LAS f32x4*)lds;
    for (int u = rel; u < n_units; u += blk_n) {
        const int mh = u & 1, nt = u >> 1;
        const int rb = ((nt >> tsh) << gsh) + ((nt & ((1 << tsh) - 1)) << 4);
        const bf16_t* ap = As + (size_t)(mh * 64 + fr) * lda + k_lo + fq * 8;
        const bf16_t* bp = Bt + (size_t)(rb + fr) * K + k_lo + fq * 8;
        f32x4 acc[4][NBF];
#pragma unroll
        for (int m = 0; m < 4; ++m)
#pragma unroll
            for (int f = 0; f < NBF; ++f) acc[m][f] = (f32x4){0.f, 0.f, 0.f, 0.f};
#pragma unroll 2
        for (int k = 0; k < KS; k += 32) {
            bf16x8 av[4], bv[NBF];
#pragma unroll
            for (int m = 0; m < 4; ++m) av[m] = *(const bf16x8*)(ap + (size_t)m * 16 * lda + k);
#pragma unroll
            for (int f = 0; f < NBF; ++f) bv[f] = *(const bf16x8*)(bp + (size_t)f * foff * K + k);
#pragma unroll
            for (int m = 0; m < 4; ++m)
#pragma unroll
                for (int f = 0; f < NBF; ++f) acc[m][f] = __builtin_amdgcn_mfma_f32_16x16x32_bf16(bv[f], av[m], acc[m][f], 0, 0, 0);
        }
#pragma unroll
        for (int m = 0; m < 4; ++m)
#pragma unroll
            for (int f = 0; f < NBF; ++f) red[((wid * 4 + m) * NBF + f) * 64 + lane] = acc[m][f];
        __syncthreads();
        if (wid < 4) { f32x4 v[NBF];
#pragma unroll
            for (int f = 0; f < NBF; ++f) { v[f] = red[((0 * 4 + wid) * NBF + f) * 64 + lane];
#pragma unroll
                for (int w = 1; w < 8; ++w) v[f] += red[((w * 4 + wid) * NBF + f) * 64 + lane]; }
            E(mh * 64 + wid * 16 + fr, nt, fq * 4, v); }
        __syncthreads();
    }
}
__device__ __forceinline__ u32x2 pack4(f32x4 o) { u32x2 w; w.x = cvt_pk_bf16(o[0], o[1]); w.y = cvt_pk_bf16(o[2], o[3]); return w; }
__device__ __forceinline__ f32x4 unpack4(u32x2 w) { f32x4 a; a[0] = __uint_as_float(w.x << 16); a[1] = __uint_as_float(w.x & 0xffff0000u); a[2] = __uint_as_float(w.y << 16); a[3] = __uint_as_float(w.y & 0xffff0000u); return a; }
struct SkGU { bf16_t* act;
    __device__ __forceinline__ void operator()(int sr, int nt, int c4, const f32x4* v) const { f32x4 o;
#pragma unroll
        for (int j = 0; j < 4; ++j) o[j] = silu_f(v[0][j]) * v[1][j];
        *(u32x2*)(act + (size_t)(NP + sr) * FF + nt * 16 + c4) = pack4(o); } };
struct SkRes { const float* baseS; float* out; const float* gate; float gs;
    __device__ __forceinline__ void operator()(int sr, int nt, int c4, const f32x4* v) const { const int col = nt * 16 + c4;
        const f32x4 b = *(const f32x4*)(baseS + (size_t)sr * D + col), gg = *(const f32x4*)(gate + (size_t)(NB + sr) * NMOD + col);
        *(f32x4*)(out + (size_t)(NP + sr) * D + col) = b + gs * gg * v[0]; } };
struct SkWinA { float* P; bf16_t* CB;
    __device__ __forceinline__ void operator()(int sr, int nt, int c4, const f32x4* v) const { const int col = nt * 16 + c4;
        if (col < PW) *(f32x4*)(P + (size_t)(NP + sr) * PW + col) = v[0]; else *(u32x2*)(CB + (size_t)(NP + sr) * CWD + col - PW) = pack4(v[0]); } };
struct SkWinU { float* U;
    __device__ __forceinline__ void operator()(int sr, int nt, int c4, const f32x4* v) const { *(f32x4*)(U + (size_t)(NP + sr) * CWD + nt * 16 + c4) = v[0] * v[1]; } };
struct SkWinG { bf16_t* SGA; bf16_t* SGB;
    __device__ __forceinline__ void operator()(int sr, int nt, int c4, const f32x4* v) const { const int col = nt * 16 + c4; f32x4 o;
#pragma unroll
        for (int j = 0; j < 4; ++j) o[j] = sigm_f(v[0][j]);
        if (col < D) *(u32x2*)(SGA + (size_t)(NP + sr) * D + col) = pack4(o); else *(u32x2*)(SGB + (size_t)(NP + sr) * D + col - D) = pack4(o); } };
struct SkGrp { bf16_t* AP; const float* scale; int g;
    __device__ __forceinline__ void operator()(int sr, int nt, int c4, const f32x4* v) const { const int col = g * 256 + nt * 16 + c4;
        *(u32x2*)(AP + (size_t)(NP + sr) * PW + col) = pack4(v[0] * *(const f32x4*)(scale + col)); } };
template <int MODE> struct SkBr { const bf16_t* SG; bf16_t* TA; bf16_t* MO;
    __device__ __forceinline__ void operator()(int sr, int nt, int c4, const f32x4* v) const { const size_t o = (size_t)(NP + sr) * D + nt * 16 + c4;
        f32x4 r = unpack4(*(const u32x2*)(SG + o)) * v[0];
        if (MODE == 1) { r += unpack4(*(const u32x2*)(TA + o)); *(u32x2*)(MO + o) = pack4(r); } else *(u32x2*)(TA + o) = pack4(r); } };

__device__ __forceinline__ void grid_barrier(unsigned* ctr, unsigned target, int wid) {
    asm volatile("s_waitcnt vmcnt(0) lgkmcnt(0)" ::: "memory");
    __builtin_amdgcn_s_barrier();
    if (wid == 0) {
        if (lane_id_v() == 0) {
            __builtin_amdgcn_fence(__ATOMIC_RELEASE, "agent");
            __hip_atomic_fetch_add(ctr, 1u, __ATOMIC_RELAXED, __HIP_MEMORY_SCOPE_AGENT);
            while (__hip_atomic_load(ctr, __ATOMIC_RELAXED, __HIP_MEMORY_SCOPE_AGENT) < target) __builtin_amdgcn_s_sleep(2);
        }
        __builtin_amdgcn_fence(__ATOMIC_ACQUIRE, "agent");
        asm volatile("s_waitcnt vmcnt(0)" ::: "memory");
    }
    __builtin_amdgcn_s_barrier();
    asm volatile("" ::: "memory");
}

constexpr int N_PHASES = 16;
__global__ void __launch_bounds__(NTHREADS, 2) fwd_kernel(Args a) {
    extern __shared__ __attribute__((aligned(16))) unsigned char lds_raw[];
    LAS unsigned char* lds = (LAS unsigned char*)lds_raw;
    const int G = gridDim.x, bx = blockIdx.x, wid = __builtin_amdgcn_readfirstlane(threadIdx.x >> 6);
    unsigned char* ws = a.ws;
    float* mod = (float*)(ws + WS_MOD); bf16_t* H = (bf16_t*)(ws + WS_H); float* XR = (float*)(ws + WS_XR); bf16_t* ACT = (bf16_t*)(ws + WS_R1);
#if ONE_LAUNCH
    cg::this_grid().sync();
#define SEAM(k) do { if ((k) + 1 < a.ph_hi) grid_barrier((unsigned*)(ws + WS_CTL) + (k), (unsigned)G, wid); } while (0)
#else
#define SEAM(k) do { } while (0)
#endif
#define IN(k) (a.ph_lo <= (k) && (k) < a.ph_hi)
#ifdef DBG_STOP
#define DBG_DUMP(k, expr) do { if ((k) == DBG_STOP) { const size_t n_out = (size_t)MR * D + (size_t)NB * 17 * PW + (size_t)NS * 17 * PW; \
        for (size_t i = (size_t)bx * NTHREADS + wid * 64 + lane_id_v(); i < n_out; i += (size_t)G * NTHREADS) a.out[i] = (expr); return; } } while (0)
#else
#define DBG_DUMP(k, expr) do { } while (0)
#endif
    pg8::StaticOrder S;
    if (IN(0)) { p0_prologue(a, lds, G, wid); SEAM(0); }
    if (IN(1)) { pg8::Gemm g{(const bf16_t*)(ws + WS_CS), (const bf16_t*)(ws + WS_R1), D, D, 0}; S.init(1, NMOD / 256, G, bx); EpiMod E{mod, a.in[7]}; pg8::gemm_phase(lds, g, S, E, wid); SEAM(1); DBG_DUMP(1, i < (size_t)256 * NMOD ? mod[i] : 0.f); }
    if (IN(2)) { rowmod_phase(a.in[0], a.in[1], a.in[8], mod, 0, H, G, wid); SEAM(2); }
    const int PT = NP / 256;
    const bf16_t* Hs = H + (size_t)NP * D; const bf16_t* ACTs = ACT + (size_t)NP * FF; float* XRs = XR + (size_t)NP * D;
    const int PLAIN = 30;
    if (IN(3)) { pg8::Gemm g{H, (const bf16_t*)(ws + WS_WGU1), D, D, 0}; S.init(PT, 2 * FF / 256, G, bx); EpiGU E{ACT}; pg8::gemm_phase(lds, g, S, E, wid);
        SkGU SE{ACT}; skinny_phase<2>(lds, Hs, D, (const bf16_t*)(ws + WS_WGU1), D, FF / 16, 3, 8, 128, SE, bx, G / 2, G - G / 2, wid); SEAM(3); }
    if (IN(4)) { pg8::Gemm g{ACT, (const bf16_t*)(ws + WS_WD1), FF, FF, 0}; S.init(PT, D / 256, G, bx); EpiRes E{a.in[0], a.in[1], XR, mod + 2 * D, 0.5f}; pg8::gemm_phase(lds, g, S, E, wid);
        SkRes SE{a.in[1], XR, mod + 2 * D, 0.5f}; skinny_phase<1>(lds, ACTs, FF, (const bf16_t*)(ws + WS_WD1), FF, D / 16, PLAIN, 0, 0, SE, bx, 0, G, wid); SEAM(4); }
    if (IN(5)) { rowmod_phase(XR, XR + (size_t)NP * D, a.in[12], mod, 3, H, G, wid); SEAM(5); }
    if (IN(6)) { pg8::Gemm g{H, (const bf16_t*)(ws + WS_WIN), D, D, 0}; S.init(PT, INC / 256, G, bx);
        EpiWin E{(float*)(ws + WS_P), (bf16_t*)(ws + WS_CB), (float*)(ws + WS_U), (bf16_t*)(ws + WS_SGA), (bf16_t*)(ws + WS_SGB)}; pg8::gemm_phase(lds, g, S, E, wid);
        const bf16_t* Win = (const bf16_t*)(ws + WS_WIN);
        SkWinA SA{(float*)(ws + WS_P), (bf16_t*)(ws + WS_CB)}; skinny_phase<1>(lds, Hs, D, Win, D, 2048 / 16, PLAIN, 0, 0, SA, bx, 0, G, wid);
        SkWinU SU{(float*)(ws + WS_U)}; skinny_phase<2>(lds, Hs, D, Win + (size_t)2048 * D, D, 1024 / 16, 3, 8, 128, SU, bx, G / 2, G - G / 2, wid);
        SkWinG SG{(bf16_t*)(ws + WS_SGA), (bf16_t*)(ws + WS_SGB)}; skinny_phase<1>(lds, Hs, D, Win + (size_t)4096 * D, D, 4096 / 16, PLAIN, 0, 0, SG, bx, 0, G, wid); SEAM(6); }
    if (IN(7)) { mixer_phase(a, G, wid); SEAM(7); }
    if (IN(8)) { pg8::Gemm g{(const bf16_t*)(ws + WS_AIN), (const bf16_t*)(ws + WS_WGRP), PW, 256, 256}; S.init(PT, PW / 256, G, bx); EpiGrp E{(bf16_t*)(ws + WS_AP), a.in[15], 0}; pg8::gemm_phase(lds, g, S, E, wid);
        for (int gi = 0; gi < 4; ++gi) { SkGrp SE{(bf16_t*)(ws + WS_AP), a.in[15], gi};
            skinny_phase<1>(lds, (const bf16_t*)(ws + WS_AIN) + (size_t)NP * PW + gi * 256, PW, (const bf16_t*)(ws + WS_WGRP) + (size_t)gi * 65536, 256, 16, PLAIN, 0, 0, SE, bx, G / 2 + gi * (G / 8), G / 8, wid); }
        SEAM(8); }
    if (IN(9)) { pg8::Gemm g{(const bf16_t*)(ws + WS_AP), (const bf16_t*)(ws + WS_WA), PW, PW, 0}; S.init(PT, D / 256, G, bx); EpiBr<0> E{(const bf16_t*)(ws + WS_SGA), (bf16_t*)(ws + WS_TA), nullptr}; pg8::gemm_phase(lds, g, S, E, wid);
        SkBr<0> SE{(const bf16_t*)(ws + WS_SGA), (bf16_t*)(ws + WS_TA), nullptr}; skinny_phase<1>(lds, (const bf16_t*)(ws + WS_AP) + (size_t)NP * PW, PW, (const bf16_t*)(ws + WS_WA), PW, D / 16, PLAIN, 0, 0, SE, bx, 0, G, wid); SEAM(9); }
    if (IN(10)) { pg8::Gemm g{(const bf16_t*)(ws + WS_V), (const bf16_t*)(ws + WS_WB), CWD, CWD, 0}; S.init(PT, D / 256, G, bx); EpiBr<1> E{(const bf16_t*)(ws + WS_SGB), (bf16_t*)(ws + WS_TA), H}; pg8::gemm_phase(lds, g, S, E, wid);
        SkBr<1> SE{(const bf16_t*)(ws + WS_SGB), (bf16_t*)(ws + WS_TA), H}; skinny_phase<1>(lds, (const bf16_t*)(ws + WS_V) + (size_t)NP * CWD, CWD, (const bf16_t*)(ws + WS_WB), CWD, D / 16, PLAIN, 0, 0, SE, bx, 0, G, wid); SEAM(10); }
    if (IN(11)) { pg8::Gemm g{H, (const bf16_t*)(ws + WS_WO), D, D, 0}; S.init(PT, D / 256, G, bx); EpiRes E{XR, XRs, XR, mod + 5 * D, 1.0f}; pg8::gemm_phase(lds, g, S, E, wid);
        SkRes SE{XRs, XR, mod + 5 * D, 1.0f}; skinny_phase<1>(lds, Hs, D, (const bf16_t*)(ws + WS_WO), D, D / 16, PLAIN, 0, 0, SE, bx, 0, G, wid); SEAM(11); }
    if (IN(12)) { rowmod_phase(XR, XR + (size_t)NP * D, a.in[21], mod, 6, H, G, wid); SEAM(12); }
    if (IN(13)) { pg8::Gemm g{H, (const bf16_t*)(ws + WS_WGU2), D, D, 0}; S.init(PT, 2 * FF / 256, G, bx); EpiGU E{ACT}; pg8::gemm_phase(lds, g, S, E, wid);
        SkGU SE{ACT}; skinny_phase<2>(lds, Hs, D, (const bf16_t*)(ws + WS_WGU2), D, FF / 16, 3, 8, 128, SE, bx, G / 2, G - G / 2, wid); SEAM(13); }
    if (IN(14)) { pg8::Gemm g{ACT, (const bf16_t*)(ws + WS_WD2), FF, FF, 0}; S.init(PT, D / 256, G, bx); EpiRes E{XR, XRs, XR, mod + 8 * D, 0.5f}; pg8::gemm_phase(lds, g, S, E, wid);
        SkRes SE{XRs, XR, mod + 8 * D, 0.5f}; skinny_phase<1>(lds, ACTs, FF, (const bf16_t*)(ws + WS_WD2), FF, D / 16, PLAIN, 0, 0, SE, bx, 0, G, wid); SEAM(14); }
    if (IN(15)) { final_norm_phase(XR, a.in[25], a.out, G, wid); }
#undef IN
#undef SEAM
}

extern "C" void kernel_launch(void* const* d_in, const int* in_sizes, int n_in, void* d_out, int out_size, void* d_ws, size_t ws_size, hipStream_t stream) {
    static int grid = 0;
    if (grid == 0) {
        if (n_in != 26 || ws_size < WS_END) { fprintf(stderr, "kernel_launch: unexpected n_in %d / ws %zu (need %zu)\n", n_in, ws_size, (size_t)WS_END); grid = -1; return; }
        int dev = 0, cus = 0, per_cu = 0;
        (void)hipGetDevice(&dev); (void)hipDeviceGetAttribute(&cus, hipDeviceAttributeMultiprocessorCount, dev);
        if (hipFuncSetAttribute((const void*)fwd_kernel, hipFuncAttributeMaxDynamicSharedMemorySize, LDS_BYTES) != hipSuccess) { fprintf(stderr, "kernel_launch: hipFuncSetAttribute failed\n"); grid = -1; return; }
        if (hipOccupancyMaxActiveBlocksPerMultiprocessor(&per_cu, (const void*)fwd_kernel, NTHREADS, LDS_BYTES) != hipSuccess || per_cu < 1) { fprintf(stderr, "kernel_launch: occupancy query gives %d\n", per_cu); per_cu = 1; }
        (void)hipGetLastError();
        grid = cus * 1;
    }
    if (grid < 0) return;
    Args a{};
    for (int i = 0; i < 26; ++i) a.in[i] = (const float*)d_in[i];
    a.out = (float*)d_out; a.ws = (unsigned char*)d_ws;
#if ONE_LAUNCH
    a.ph_lo = 0; a.ph_hi = N_PHASES;
    (void)hipMemsetAsync((unsigned char*)d_ws + WS_CTL, 0, 256, stream);
    void* args[] = {&a};
    hipError_t e = hipLaunchCooperativeKernel((const void*)fwd_kernel, dim3(grid), dim3(NTHREADS), args, LDS_BYTES, stream);
    if (e != hipSuccess) fprintf(stderr, "cooperative launch failed: %s (grid %d)\n", hipGetErrorString(e), grid);
#else
    for (int ph = 0; ph < N_PHASES; ++ph) { a.ph_lo = ph; a.ph_hi = ph + 1; hipLaunchKernelGGL(fwd_kernel, dim3(grid), dim3(NTHREADS), LDS_BYTES, stream, a); }
#endif
}
```

```cpp
#include <hip/hip_runtime.h>
#include <hip/hip_cooperative_groups.h>
#include <cstdio>
#include <cstdint>
#ifndef ONE_LAUNCH
#define ONE_LAUNCH 1
#endif
namespace cg = cooperative_groups;

#define LAS __attribute__((address_space(3)))
typedef unsigned short bf16_t;
typedef short bf16x8 __attribute__((ext_vector_type(8)));
typedef float f32x4 __attribute__((ext_vector_type(4)));
typedef unsigned u32x4 __attribute__((ext_vector_type(4)));
typedef unsigned u32x2 __attribute__((ext_vector_type(2)));

constexpr int D = 2048, FF = 5632, NP = 8192, NS = 128, MR = NP + NS, MP = 8448, NMT = MP / 256;
constexpr int INC = 8192, PW = 1024, CWD = 1024, NMOD = 9 * D, SEQ = 2048, NB = 4;
constexpr float EPS = 1e-6f;
constexpr int NTHREADS = 512;
constexpr int LDS_BYTES = 131072 + 256;

constexpr size_t al256(size_t x) { return (x + 255) & ~(size_t)255; }
constexpr size_t WS_WGU1 = 0;
constexpr size_t WS_WD1 = WS_WGU1 + (size_t)2 * FF * D * 2;
constexpr size_t WS_WIN = WS_WD1 + (size_t)D * FF * 2;
constexpr size_t WS_WGRP = WS_WIN + (size_t)INC * D * 2;
constexpr size_t WS_WA = WS_WGRP + (size_t)PW * 256 * 2;
constexpr size_t WS_WB = WS_WA + (size_t)D * PW * 2;
constexpr size_t WS_WO = WS_WB + (size_t)D * CWD * 2;
constexpr size_t WS_WGU2 = WS_WO + (size_t)D * D * 2;
constexpr size_t WS_WD2 = WS_WGU2 + (size_t)2 * FF * D * 2;
constexpr size_t WS_MOD = WS_WD2 + (size_t)D * FF * 2;
constexpr size_t WS_CS = WS_MOD + (size_t)256 * NMOD * 4;
constexpr size_t WS_H = WS_CS + (size_t)256 * D * 2;
constexpr size_t WS_XR = WS_H + (size_t)MP * D * 2;
constexpr size_t WS_R1 = WS_XR + (size_t)MP * D * 4;
constexpr size_t R1_BYTES = (size_t)MP * FF * 2;
constexpr size_t WS_P = WS_R1;
constexpr size_t WS_U = WS_P + (size_t)MP * PW * 4;
constexpr size_t WS_CB = WS_U + (size_t)MP * CWD * 4;
static_assert(WS_CB + (size_t)MP * CWD * 2 <= WS_R1 + R1_BYTES, "R1 overlay");
static_assert((size_t)NMOD * D * 2 <= R1_BYTES, "Wada overlay");
constexpr size_t WS_SGA = WS_R1 + R1_BYTES;
constexpr size_t WS_SGB = WS_SGA + (size_t)MP * D * 2;
constexpr size_t WS_AIN = WS_SGB + (size_t)MP * D * 2;
constexpr size_t WS_AP = WS_AIN + (size_t)MP * PW * 2;
constexpr size_t WS_V = WS_AP + (size_t)MP * PW * 2;
constexpr size_t WS_TA = WS_V + (size_t)MP * CWD * 2;
constexpr size_t WS_CTL = WS_TA + (size_t)MP * D * 2;
constexpr size_t WS_TS = WS_CTL + 16384;
constexpr size_t WS_END = WS_TS + 1024;

typedef float f32x2_t __attribute__((ext_vector_type(2)));
typedef __bf16 bf16x2_t __attribute__((ext_vector_type(2)));
__device__ __forceinline__ unsigned cvt_pk_bf16(float lo, float hi) { const f32x2_t v = {lo, hi}; const bf16x2_t b = __builtin_convertvector(v, bf16x2_t); return __builtin_bit_cast(unsigned, b); }
__device__ __forceinline__ u32x4 pack8(f32x4 a, f32x4 b) { u32x4 w; w.x = cvt_pk_bf16(a[0], a[1]); w.y = cvt_pk_bf16(a[2], a[3]); w.z = cvt_pk_bf16(b[0], b[1]); w.w = cvt_pk_bf16(b[2], b[3]); return w; }
__device__ __forceinline__ void unpack8(u32x4 w, f32x4& a, f32x4& b) {
    a[0] = __uint_as_float(w.x << 16); a[1] = __uint_as_float(w.x & 0xffff0000u); a[2] = __uint_as_float(w.y << 16); a[3] = __uint_as_float(w.y & 0xffff0000u);
    b[0] = __uint_as_float(w.z << 16); b[1] = __uint_as_float(w.z & 0xffff0000u); b[2] = __uint_as_float(w.w << 16); b[3] = __uint_as_float(w.w & 0xffff0000u); }
__device__ __forceinline__ float sigm_f(float x) { return __builtin_amdgcn_rcpf(1.0f + __expf(-x)); }
__device__ __forceinline__ float silu_f(float x) { return x * sigm_f(x); }
__device__ __forceinline__ int lane_id_v() { int l; asm volatile("v_mbcnt_lo_u32_b32 %0, -1, 0\n\tv_mbcnt_hi_u32_b32 %0, -1, %0" : "=v"(l)); return l; }
__device__ __forceinline__ int bidx(int row) { return row < NP ? (row >> 11) : (row - NP + NB); }

namespace pg8 {
constexpr int BM = 256, BK = 64, HALF = 128, HTB = HALF * BK * 2, STAGE_BYTES = 8 * HTB, NXCD = 8, WGM = 8;
__host__ __device__ __forceinline__ int lds_byte(int r, int c) { const int st = (r >> 4) * 2 + (c >> 5), rr = r & 15, cc = c & 31, ob = rr * 64 + cc * 2; return st * 1024 + (ob ^ (((ob >> 9) & 1) << 5)); }
__host__ __device__ __forceinline__ void stage_rc(int b, int& R, int& C) { const int st = b / 1024, sb = b % 1024, swz = sb ^ (((sb >> 9) & 1) << 5); R = (st >> 1) * 16 + swz / 64; C = (st & 1) * 32 + (swz % 64) / 2; }
__host__ __device__ __forceinline__ int perm32(int rho) { const int n = rho >> 4, i = rho & 15; return 8 * (i >> 2) + 4 * n + (i & 3); }

struct Unit { int pm, pn; };
struct Gemm { const bf16_t* A; const bf16_t* Bt; int lda, K, a_pn_off; };

struct StaticOrder {
    int nM, nN, nwg, G, c, n_extra, extra_pm;
    __device__ void init(int nM_, int nN_, int G_, int c_, int n_extra_ = 0, int extra_pm_ = 0) { nM = nM_; nN = nN_; nwg = nM * nN; G = G_; c = c_; n_extra = n_extra_; extra_pm = extra_pm_; }
    __device__ bool next(int i, Unit& u) const {
        const long L = (long)i * G + c;
        if (L >= nwg) { if (L >= nwg + n_extra) return false; u.pm = extra_pm; u.pn = (int)(L - nwg); return true; }
        int wgid = (int)L; { const int q = nwg / NXCD, r = nwg % NXCD, xcd = wgid % NXCD, off = wgid / NXCD; wgid = (xcd < r ? xcd * (q + 1) : r * (q + 1) + (xcd - r) * q) + off; }
        const int nig = WGM * nN, gid = wgid / nig, fm = gid * WGM, gsz = (nM - fm) < WGM ? (nM - fm) : WGM;
        u.pm = fm + ((wgid % nig) % gsz); u.pn = (wgid % nig) / gsz; return true;
    }
};

template <class Epi>
__device__ __forceinline__ void gemm_phase(LAS unsigned char* lds, const Gemm g, const StaticOrder& S, const Epi& E, const int wid) {
    const int lane = lane_id_v(), tid = wid * 64 + lane, wr = wid >> 2, wc = wid & 3, fr = lane & 15, fq = lane >> 4;
    const int K = g.K, nt = K / BK, lda = g.lda;
    unsigned voffA[2], voffB[2];
#pragma unroll
    for (int i = 0; i < 2; ++i) { int R, C; stage_rc(tid * 16 + i * 8192, R, C); const int Rb = (R & ~31) + perm32(R & 31);
        voffA[i] = (unsigned)(R * lda + C) * 2u; voffB[i] = (unsigned)(Rb * K + C) * 2u; }
    const size_t kstep = (size_t)(BK * 2);
    const size_t hstepA = (size_t)HALF * lda * 2, tstepA = 2 * hstepA;
    const size_t hstepB = (size_t)HALF * K * 2, tstepB = 2 * hstepB;
    const size_t pnA = (size_t)g.a_pn_off * 2;
    const unsigned ldsw = (unsigned)wid * 1024u;
    const int aoff = lds_byte(wr * 64 + fr, fq * 8), boff = lds_byte(wc * 32 + fr, fq * 8);
#define PG8_SA(b, h) (((b) * 2 + (h)) * HTB)
#define PG8_SB(b, h) ((4 + (b) * 2 + (h)) * HTB)
#define PG8_STAGE(bufoff, gbase, voff) do { _Pragma("unroll") for (int _i = 0; _i < 2; ++_i) \
        __builtin_amdgcn_global_load_lds((const unsigned*)((const char*)(gbase) + (voff)[_i]), (LAS unsigned*)(lds + (bufoff) + ldsw + _i * 8192), 16, 0, 0); } while (0)
#define PG8_LDA(dst, b, h) do { _Pragma("unroll") for (int m = 0; m < 4; ++m) _Pragma("unroll") for (int k = 0; k < 2; ++k) dst[m][k] = *(const LAS bf16x8*)(lds + PG8_SA(b, h) + aoff + m * 2048 + k * 1024); } while (0)
#define PG8_LDB(dst, b, h) do { _Pragma("unroll") for (int n = 0; n < 2; ++n) _Pragma("unroll") for (int k = 0; k < 2; ++k) dst[n][k] = *(const LAS bf16x8*)(lds + PG8_SB(b, h) + boff + n * 2048 + k * 1024); } while (0)
#define PG8_MMA(ai, bj, At, Bt) do { __builtin_amdgcn_s_setprio(1); _Pragma("unroll") for (int m = 0; m < 4; ++m) _Pragma("unroll") for (int n = 0; n < 2; ++n) _Pragma("unroll") for (int k = 0; k < 2; ++k) \
        acc[ai][bj][m][n] = __builtin_amdgcn_mfma_f32_16x16x32_bf16(Bt[n][k], At[m][k], acc[ai][bj][m][n], 0, 0, 0); __builtin_amdgcn_s_setprio(0); } while (0)
#define PG8_WAIT_V(n) asm volatile("s_waitcnt vmcnt(" #n ")" ::: "memory")
#define PG8_WAIT_L(n) asm volatile("s_waitcnt lgkmcnt(" #n ")" ::: "memory")
#define PG8_BAR __builtin_amdgcn_s_barrier()
#define PG8_SCHED __builtin_amdgcn_sched_barrier(0)
    Unit cur, nxt; int ui = 0;
    if (!S.next(0, cur)) return;
    f32x4 acc[2][2][4][2];
#pragma unroll
    for (int a = 0; a < 2; ++a)
#pragma unroll
        for (int b = 0; b < 2; ++b)
#pragma unroll
            for (int m = 0; m < 4; ++m)
#pragma unroll
                for (int n = 0; n < 2; ++n) acc[a][b][m][n] = (f32x4){0.f, 0.f, 0.f, 0.f};
    bf16x8 At[4][2], B0[2][2], B1[2][2];
    const char* cA = (const char*)g.A + (size_t)cur.pm * tstepA + (size_t)cur.pn * pnA; const char* cB = (const char*)g.Bt + (size_t)cur.pn * tstepB;
    PG8_STAGE(PG8_SB(0, 0), cB, voffB); PG8_STAGE(PG8_SB(0, 1), cB + hstepB, voffB); PG8_STAGE(PG8_SA(0, 0), cA, voffA); PG8_STAGE(PG8_SA(0, 1), cA + hstepA, voffA);
    if (wr == 1) PG8_BAR;
    PG8_WAIT_V(2); PG8_BAR;
    PG8_STAGE(PG8_SB(1, 0), cB + kstep, voffB); PG8_STAGE(PG8_SA(1, 0), cA + kstep, voffA); PG8_STAGE(PG8_SB(1, 1), cB + hstepB + kstep, voffB);
    PG8_WAIT_V(6); PG8_BAR;
    for (;;) {
        const bool has_next = S.next(ui + 1, nxt);
        const char* nA = has_next ? (const char*)g.A + (size_t)nxt.pm * tstepA + (size_t)nxt.pn * pnA : cA; const char* nB = has_next ? (const char*)g.Bt + (size_t)nxt.pn * tstepB : cB;
#pragma clang loop unroll(disable)
        for (int t = 0; t < nt; t += 2) {
            const bool last = (t == nt - 2);
            const char* a1 = cA + (size_t)(t + 1) * kstep;
            const char* a2 = last ? nA : cA + (size_t)(t + 2) * kstep; const char* b2 = last ? nB : cB + (size_t)(t + 2) * kstep;
            const char* a3 = a2 + kstep; const char* b3 = b2 + kstep;
            PG8_LDB(B0, 0, 0); PG8_LDB(B1, 0, 1); PG8_SCHED; PG8_LDA(At, 0, 0); PG8_STAGE(PG8_SA(1, 1), a1 + hstepA, voffA);
            PG8_WAIT_V(8); PG8_WAIT_L(0); PG8_BAR; PG8_MMA(0, 0, At, B0); PG8_MMA(0, 1, At, B1); PG8_BAR; PG8_SCHED;
            PG8_LDA(At, 0, 1); PG8_STAGE(PG8_SB(0, 0), b2, voffB); PG8_STAGE(PG8_SB(0, 1), b2 + hstepB, voffB); PG8_STAGE(PG8_SA(0, 0), a2, voffA);
            PG8_WAIT_V(8); PG8_WAIT_L(0); PG8_BAR; PG8_MMA(1, 0, At, B0); PG8_MMA(1, 1, At, B1); PG8_BAR; PG8_SCHED;
            PG8_LDB(B0, 1, 0); PG8_LDB(B1, 1, 1); PG8_SCHED; PG8_LDA(At, 1, 0); PG8_STAGE(PG8_SA(0, 1), a2 + hstepA, voffA);
            PG8_WAIT_V(8); PG8_WAIT_L(0); PG8_BAR; PG8_MMA(0, 0, At, B0); PG8_MMA(0, 1, At, B1); PG8_BAR; PG8_SCHED;
            PG8_LDA(At, 1, 1); PG8_STAGE(PG8_SB(1, 0), b3, voffB); PG8_STAGE(PG8_SB(1, 1), b3 + hstepB, voffB); PG8_STAGE(PG8_SA(1, 0), a3, voffA);
            PG8_WAIT_V(8); PG8_WAIT_L(0); PG8_BAR; PG8_MMA(1, 0, At, B0); PG8_MMA(1, 1, At, B1); PG8_BAR; PG8_SCHED;
        }
        if (wr == 0) PG8_BAR;
        { const int el = lane_id_v(); E(acc, cur, wr, wc, el & 15, el >> 4); }
        if (!has_next) break;
#pragma unroll
        for (int a = 0; a < 2; ++a)
#pragma unroll
            for (int b = 0; b < 2; ++b)
#pragma unroll
                for (int m = 0; m < 4; ++m)
#pragma unroll
                    for (int n = 0; n < 2; ++n) acc[a][b][m][n] = (f32x4){0.f, 0.f, 0.f, 0.f};
        cur = nxt; cA = nA; cB = nB; ++ui;
        if (wr == 1) PG8_BAR;
    }
    PG8_WAIT_V(0);
    PG8_BAR;
#undef PG8_SA
#undef PG8_SB
#undef PG8_STAGE
#undef PG8_LDA
#undef PG8_LDB
#undef PG8_MMA
#undef PG8_WAIT_V
#undef PG8_WAIT_L
#undef PG8_BAR
#undef PG8_SCHED
}
}

using pg8::Unit;
typedef f32x4 AccT[2][2][4][2];
#define EPI_ROW(u, ai, m) ((u).pm * 256 + (ai) * 128 + wr * 64 + (m) * 16 + fr)
#define EPI_COL(u, bj) ((u).pn * 256 + (bj) * 128 + wc * 32 + fq * 8)

struct EpiMod {
    float* mod; const float* bias;
    __device__ __forceinline__ void operator()(const AccT& acc, const Unit& u, int wr, int wc, int fr, int fq) const {
#pragma unroll
        for (int bj = 0; bj < 2; ++bj) { const int col = EPI_COL(u, bj); const f32x4 b0 = *(const f32x4*)(bias + col), b1 = *(const f32x4*)(bias + col + 4);
#pragma unroll
            for (int ai = 0; ai < 2; ++ai)
#pragma unroll
                for (int m = 0; m < 4; ++m) { float* p = mod + (size_t)EPI_ROW(u, ai, m) * NMOD + col; *(f32x4*)p = acc[ai][bj][m][0] + b0; *(f32x4*)(p + 4) = acc[ai][bj][m][1] + b1; } }
    }
};
struct EpiGU {
    bf16_t* act;
    __device__ __forceinline__ void operator()(const AccT& acc, const Unit& u, int wr, int wc, int fr, int fq) const {
#pragma unroll
        for (int ai = 0; ai < 2; ++ai)
#pragma unroll
            for (int m = 0; m < 4; ++m) { f32x4 o[2];
#pragma unroll
                for (int n = 0; n < 2; ++n)
#pragma unroll
                    for (int j = 0; j < 4; ++j) o[n][j] = silu_f(acc[ai][0][m][n][j]) * acc[ai][1][m][n][j];
                *(u32x4*)(act + (size_t)EPI_ROW(u, ai, m) * FF + u.pn * 128 + wc * 32 + fq * 8) = pack8(o[0], o[1]); }
    }
};
struct EpiRes {
    const float* baseP; const float* baseS; float* out; const float* gate; float gs;
    __device__ __forceinline__ void operator()(const AccT& acc, const Unit& u, int wr, int wc, int fr, int fq) const {
#pragma unroll
        for (int ai = 0; ai < 2; ++ai)
#pragma unroll
            for (int m = 0; m < 4; ++m) { const int row = EPI_ROW(u, ai, m);
                if (row < MR) { const float* bp = row < NP ? baseP + (size_t)row * D : baseS + (size_t)(row - NP) * D; const float* gp = gate + (size_t)bidx(row) * NMOD; float* op = out + (size_t)row * D;
#pragma unroll
                    for (int bj = 0; bj < 2; ++bj) { const int col = EPI_COL(u, bj);
#pragma unroll
                        for (int n = 0; n < 2; ++n) { const f32x4 b = *(const f32x4*)(bp + col + 4 * n), gg = *(const f32x4*)(gp + col + 4 * n); *(f32x4*)(op + col + 4 * n) = b + gs * gg * acc[ai][bj][m][n]; } } }
                asm volatile("" ::: "memory"); }
    }
};
struct EpiWin {
    float* P; bf16_t* CB; float* U; bf16_t* SGA; bf16_t* SGB;
    __device__ __forceinline__ void operator()(const AccT& acc, const Unit& u, int wr, int wc, int fr, int fq) const {
        const int pn = u.pn;
        if (pn < 4) {
#pragma unroll
            for (int ai = 0; ai < 2; ++ai)
#pragma unroll
                for (int m = 0; m < 4; ++m) { float* p = P + (size_t)EPI_ROW(u, ai, m) * PW;
#pragma unroll
                    for (int bj = 0; bj < 2; ++bj) { const int col = EPI_COL(u, bj); *(f32x4*)(p + col) = acc[ai][bj][m][0]; *(f32x4*)(p + col + 4) = acc[ai][bj][m][1]; } }
        } else if (pn < 8) {
#pragma unroll
            for (int ai = 0; ai < 2; ++ai)
#pragma unroll
                for (int m = 0; m < 4; ++m) { bf16_t* p = CB + (size_t)EPI_ROW(u, ai, m) * CWD - 1024;
#pragma unroll
                    for (int bj = 0; bj < 2; ++bj) *(u32x4*)(p + EPI_COL(u, bj)) = pack8(acc[ai][bj][m][0], acc[ai][bj][m][1]); }
        } else if (pn < 16) {
#pragma unroll
            for (int ai = 0; ai < 2; ++ai)
#pragma unroll
                for (int m = 0; m < 4; ++m) { float* p = U + (size_t)EPI_ROW(u, ai, m) * CWD + (pn - 8) * 128 + wc * 32 + fq * 8;
                    *(f32x4*)p = acc[ai][0][m][0] * acc[ai][1][m][0]; *(f32x4*)(p + 4) = acc[ai][0][m][1] * acc[ai][1][m][1]; }
        } else {
            bf16_t* base = pn < 24 ? SGA - 4096 : SGB - 6144;
#pragma unroll
            for (int ai = 0; ai < 2; ++ai)
#pragma unroll
                for (int m = 0; m < 4; ++m) { bf16_t* p = base + (size_t)EPI_ROW(u, ai, m) * D;
#pragma unroll
                    for (int bj = 0; bj < 2; ++bj) { f32x4 o[2];
#pragma unroll
                        for (int n = 0; n < 2; ++n)
#pragma unroll
                            for (int j = 0; j < 4; ++j) o[n][j] = sigm_f(acc[ai][bj][m][n][j]);
                        *(u32x4*)(p + EPI_COL(u, bj)) = pack8(o[0], o[1]); } }
        }
    }
};
struct EpiGrp {
    bf16_t* AP; const float* scale; int coff;
    __device__ __forceinline__ void operator()(const AccT& acc, const Unit& u, int wr, int wc, int fr, int fq) const {
#pragma unroll
        for (int bj = 0; bj < 2; ++bj) { const int col = coff + EPI_COL(u, bj); const f32x4 s0 = *(const f32x4*)(scale + col), s1 = *(const f32x4*)(scale + col + 4);
#pragma unroll
            for (int ai = 0; ai < 2; ++ai)
#pragma unroll
                for (int m = 0; m < 4; ++m) *(u32x4*)(AP + (size_t)EPI_ROW(u, ai, m) * PW + col) = pack8(acc[ai][bj][m][0] * s0, acc[ai][bj][m][1] * s1); }
    }
};
template <int MODE> struct EpiBr {
    const bf16_t* SG; bf16_t* TA; bf16_t* MO;
    __device__ __forceinline__ void operator()(const AccT& acc, const Unit& u, int wr, int wc, int fr, int fq) const {
#pragma unroll
        for (int ai = 0; ai < 2; ++ai)
#pragma unroll
            for (int m = 0; m < 4; ++m) { const size_t ro = (size_t)EPI_ROW(u, ai, m) * D;
#pragma unroll
                for (int bj = 0; bj < 2; ++bj) { const size_t o = ro + EPI_COL(u, bj); f32x4 s0, s1; unpack8(*(const u32x4*)(SG + o), s0, s1);
                    f32x4 r0 = s0 * acc[ai][bj][m][0], r1 = s1 * acc[ai][bj][m][1];
                    if (MODE == 1) { f32x4 t0, t1; unpack8(*(const u32x4*)(TA + o), t0, t1); r0 += t0; r1 += t1; *(u32x4*)(MO + o) = pack8(r0, r1); }
                    else *(u32x4*)(TA + o) = pack8(r0, r1); }
                asm volatile("" ::: "memory"); }
    }
};

struct Args { const float* in[26]; float* out; unsigned char* ws; int ph_lo, ph_hi; };

__device__ __forceinline__ int map_row(int map, int n) {
    if (map == 1) return (n >> 7) * 256 + (n & 127);
    if (map == 2) return (n >> 7) * 256 + 128 + (n & 127);
    if (map == 3) { if (n < 2048 || n >= 4096) return n; if (n < 3072) { const int j = n - 2048; return 2048 + (j >> 7) * 256 + (j & 127); } const int j = n - 3072; return 2048 + (j >> 7) * 256 + 128 + (j & 127); }
    return n;
}
__device__ void cvt_task(LAS unsigned* T0, const float* src, bf16_t* dst, int K, int N, int dstK, int map, int& base, int G, int tid, int& par) {
    const int tn = N / 64, ntiles = (K / 128) * tn;
    const int nq = tid & 15, kp = tid >> 4;
    const int first = ((int)blockIdx.x - base % G + G) % G;
    base += ntiles;
    if (first >= ntiles) return;
    f32x4 r[2][2], rn[2][2];
    { const int kt = first / tn, ntile = first - kt * tn, k0 = kt * 128, n0 = ntile * 64;
#pragma unroll
      for (int it = 0; it < 2; ++it) { const int k = k0 + 2 * (kp + 32 * it); r[it][0] = *(const f32x4*)(src + (size_t)k * N + n0 + nq * 4); r[it][1] = *(const f32x4*)(src + (size_t)(k + 1) * N + n0 + nq * 4); } }
    for (int t = first; t < ntiles; t += G) {
        const int kt = t / tn, ntile = t - kt * tn, k0 = kt * 128, n0 = ntile * 64;
        const int t2 = t + G;
        if (t2 < ntiles) { const int kt2 = t2 / tn, ntile2 = t2 - kt2 * tn, k02 = kt2 * 128, n02 = ntile2 * 64;
#pragma unroll
            for (int it = 0; it < 2; ++it) { const int k = k02 + 2 * (kp + 32 * it); rn[it][0] = *(const f32x4*)(src + (size_t)k * N + n02 + nq * 4); rn[it][1] = *(const f32x4*)(src + (size_t)(k + 1) * N + n02 + nq * 4); } }
        LAS unsigned* T = T0 + par * (64 * 65); par ^= 1;
#pragma unroll
        for (int it = 0; it < 2; ++it) { const int kk = kp + 32 * it;
#pragma unroll
            for (int j = 0; j < 4; ++j) T[(nq * 4 + j) * 65 + kk] = cvt_pk_bf16(r[it][0][j], r[it][1][j]); }
        __syncthreads();
        const int n0d = map_row(map, n0);
#pragma unroll
        for (int ps = 0; ps < 2; ++ps) { const int nl = (tid >> 4) + 32 * ps, kq = tid & 15; u32x4 w;
            w.x = T[nl * 65 + kq * 4 + 0]; w.y = T[nl * 65 + kq * 4 + 1]; w.z = T[nl * 65 + kq * 4 + 2]; w.w = T[nl * 65 + kq * 4 + 3];
            *(u32x4*)(dst + (size_t)(n0d + nl) * dstK + k0 + kq * 8) = w; }
#pragma unroll
        for (int it = 0; it < 2; ++it) { r[it][0] = rn[it][0]; r[it][1] = rn[it][1]; }
    }
}

__device__ void p0_prologue(const Args& a, LAS unsigned char* lds, int G, int wid) {
    const int tid = wid * 64 + lane_id_v();
    unsigned char* ws = a.ws; LAS unsigned* T = (LAS unsigned*)lds; int base = 0, par = 0;
    cvt_task(T, a.in[6], (bf16_t*)(ws + WS_R1), D, NMOD, D, 0, base, G, tid, par);
    cvt_task(T, a.in[9], (bf16_t*)(ws + WS_WGU1), D, FF, D, 1, base, G, tid, par);
    cvt_task(T, a.in[10], (bf16_t*)(ws + WS_WGU1), D, FF, D, 2, base, G, tid, par);
    cvt_task(T, a.in[11], (bf16_t*)(ws + WS_WD1), FF, D, FF, 0, base, G, tid, par);
    cvt_task(T, a.in[13], (bf16_t*)(ws + WS_WIN), D, INC, D, 3, base, G, tid, par);
    for (int g = 0; g < 4; ++g) cvt_task(T, a.in[14] + (size_t)g * 65536, (bf16_t*)(ws + WS_WGRP) + (size_t)g * 65536, 256, 256, 256, 0, base, G, tid, par);
    cvt_task(T, a.in[16], (bf16_t*)(ws + WS_WA), PW, D, PW, 0, base, G, tid, par);
    cvt_task(T, a.in[19], (bf16_t*)(ws + WS_WB), CWD, D, CWD, 0, base, G, tid, par);
    cvt_task(T, a.in[20], (bf16_t*)(ws + WS_WO), D, D, D, 0, base, G, tid, par);
    cvt_task(T, a.in[22], (bf16_t*)(ws + WS_WGU2), D, FF, D, 1, base, G, tid, par);
    cvt_task(T, a.in[23], (bf16_t*)(ws + WS_WGU2), D, FF, D, 2, base, G, tid, par);
    cvt_task(T, a.in[24], (bf16_t*)(ws + WS_WD2), FF, D, FF, 0, base, G, tid, par);
    bf16_t* cs = (bf16_t*)(ws + WS_CS);
    for (int i = blockIdx.x * NTHREADS + tid; i < 256 * D / 4; i += G * NTHREADS) { const int row = i / (D / 4), c4 = (i - row * (D / 4)) * 4; u32x2 w = {0u, 0u};
        if (row < NB + NS) { const float* cp = row < NB ? a.in[2] + (size_t)row * D : a.in[3] + (size_t)(row - NB) * D; const f32x4 v = *(const f32x4*)(cp + c4);
            w.x = cvt_pk_bf16(silu_f(v[0]), silu_f(v[1])); w.y = cvt_pk_bf16(silu_f(v[2]), silu_f(v[3])); }
        *(u32x2*)(cs + (size_t)row * D + c4) = w; }
}

__device__ __forceinline__ float wave_sum(float s) {
#pragma unroll
    for (int o = 32; o >= 1; o >>= 1) s += __shfl_xor(s, o);
    return s;
}
__device__ void rowmod_phase(const float* srcP, const float* srcS, const float* normw, const float* mod, int jsh, bf16_t* h, int G, int wid) {
    const int lane = lane_id_v();
    for (int row = blockIdx.x * 8 + wid; row < MR; row += G * 8) {
        const float* src = row < NP ? srcP + (size_t)row * D : srcS + (size_t)(row - NP) * D;
        const float* sh = mod + (size_t)bidx(row) * NMOD + (size_t)jsh * D; const float* sc = sh + D;
        f32x4 v[8]; float ss = 0.f;
#pragma unroll
        for (int i = 0; i < 8; ++i) { v[i] = *(const f32x4*)(src + (i * 64 + lane) * 4); ss += v[i][0] * v[i][0] + v[i][1] * v[i][1] + v[i][2] * v[i][2] + v[i][3] * v[i][3]; }
        ss = wave_sum(ss); const float inv = rsqrtf(ss * (1.0f / D) + EPS);
#pragma unroll
        for (int i = 0; i < 8; ++i) { const int c = (i * 64 + lane) * 4; const f32x4 g4 = *(const f32x4*)(normw + c), s4 = *(const f32x4*)(sc + c), h4 = *(const f32x4*)(sh + c);
            const f32x4 o = (v[i] * inv) * g4 * (1.0f + s4) + h4; u32x2 w; w.x = cvt_pk_bf16(o[0], o[1]); w.y = cvt_pk_bf16(o[2], o[3]); *(u32x2*)(h + (size_t)row * D + c) = w; }
    }
}
__device__ void final_norm_phase(const float* xr, const float* normw, float* out, int G, int wid) {
    const int lane = lane_id_v();
    for (int row = blockIdx.x * 8 + wid; row < MR; row += G * 8) {
        const float* src = xr + (size_t)row * D; f32x4 v[8]; float ss = 0.f;
#pragma unroll
        for (int i = 0; i < 8; ++i) { v[i] = *(const f32x4*)(src + (i * 64 + lane) * 4); ss += v[i][0] * v[i][0] + v[i][1] * v[i][1] + v[i][2] * v[i][2] + v[i][3] * v[i][3]; }
        ss = wave_sum(ss); const float inv = rsqrtf(ss * (1.0f / D) + EPS);
#pragma unroll
        for (int i = 0; i < 8; ++i) { const int c = (i * 64 + lane) * 4; *(f32x4*)(out + (size_t)row * D + c) = (v[i] * inv) * *(const f32x4*)(normw + c); }
    }
}
__device__ void mixer_phase(const Args& a, int G, int wid) {
    unsigned char* ws = a.ws;
    const float* P = (const float*)(ws + WS_P); const float* U = (const float*)(ws + WS_U); const bf16_t* CB = (const bf16_t*)(ws + WS_CB);
    bf16_t* AIN = (bf16_t*)(ws + WS_AIN); bf16_t* V = (bf16_t*)(ws + WS_V);
    const float* state_pool = a.in[4]; const float* state_conv = a.in[5]; const float* conv_w = a.in[17]; const float* conv_b = a.in[18];
    float* o_pp = a.out + (size_t)MR * D; float* o_cp = o_pp + (size_t)NB * 15 * PW; float* o_cs; float* o_ps = o_cp + (size_t)NB * 2 * CWD; o_cs = o_ps + (size_t)NS * 15 * PW;
    const int tid = wid * 64 + lane_id_v();
    const f32x4 z4 = {0.f, 0.f, 0.f, 0.f};
    if (wid < 4) {
        const int c = tid * 4, g = tid >> 6, w = 2 << g;
        for (int ch = blockIdx.x; ch < NP / 32; ch += G) {
            const int r0 = ch * 32, b = r0 >> 11, t0 = r0 & (SEQ - 1);
            f32x4 s = z4;
            for (int i = 1; i < w; ++i) if (t0 - i >= 0) s += *(const f32x4*)(P + (size_t)(r0 - i) * PW + c);
#pragma unroll 4
            for (int j = 0; j < 32; ++j) { const int row = r0 + j, t = t0 + j;
                const f32x4 pc = *(const f32x4*)(P + (size_t)row * PW + c);
                f32x4 old = z4; if (t - (w - 1) >= 0) old = *(const f32x4*)(P + (size_t)(row - (w - 1)) * PW + c);
                s += pc; const int cnt = (t + 1) < w ? (t + 1) : w;
                const f32x4 o = s * (1.0f / (float)cnt) - pc; u32x2 wv; wv.x = cvt_pk_bf16(o[0], o[1]); wv.y = cvt_pk_bf16(o[2], o[3]); *(u32x2*)(AIN + (size_t)row * PW + c) = wv;
                if (t >= SEQ - 15) *(f32x4*)(o_pp + ((size_t)b * 15 + (t - (SEQ - 15))) * PW + c) = pc;
                s -= old; }
        }
        for (int b = blockIdx.x; b < NS; b += G) { const int row = NP + b;
            const f32x4 pc = *(const f32x4*)(P + (size_t)row * PW + c); f32x4 s = pc; const float* sp = state_pool + (size_t)b * 15 * PW + c;
            for (int i = 1; i < w; ++i) s += *(const f32x4*)(sp + (size_t)(15 - i) * PW);
            float* op = o_ps + (size_t)b * 15 * PW + c;
#pragma unroll
            for (int i = 0; i < 14; ++i) *(f32x4*)(op + (size_t)i * PW) = *(const f32x4*)(sp + (size_t)(i + 1) * PW);
            *(f32x4*)(op + (size_t)14 * PW) = pc;
            const f32x4 o = s * (1.0f / (float)w) - pc; u32x2 wv; wv.x = cvt_pk_bf16(o[0], o[1]); wv.y = cvt_pk_bf16(o[2], o[3]); *(u32x2*)(AIN + (size_t)row * PW + c) = wv; }
    } else {
        const int c = (tid - 256) * 4;
        const f32x4 w0 = *(const f32x4*)(conv_w + c), w1 = *(const f32x4*)(conv_w + CWD + c), w2 = *(const f32x4*)(conv_w + 2 * CWD + c), bb = *(const f32x4*)(conv_b + c);
        for (int ch = blockIdx.x; ch < NP / 32; ch += G) {
            const int r0 = ch * 32, b = r0 >> 11, t0 = r0 & (SEQ - 1);
            f32x4 u0 = z4, u1 = z4;
            if (t0 > 0) { u0 = *(const f32x4*)(U + (size_t)(r0 - 2) * CWD + c); u1 = *(const f32x4*)(U + (size_t)(r0 - 1) * CWD + c); }
#pragma unroll 4
            for (int j = 0; j < 32; ++j) { const int row = r0 + j, t = t0 + j;
                const f32x4 u2 = *(const f32x4*)(U + (size_t)row * CWD + c);
                const u32x2 cw = *(const u32x2*)(CB + (size_t)row * CWD + c); f32x4 cb;
                cb[0] = __uint_as_float(cw.x << 16); cb[1] = __uint_as_float(cw.x & 0xffff0000u); cb[2] = __uint_as_float(cw.y << 16); cb[3] = __uint_as_float(cw.y & 0xffff0000u);
                const f32x4 y = bb + u0 * w0 + u1 * w1 + u2 * w2;
                const f32x4 o = cb * y; u32x2 wv; wv.x = cvt_pk_bf16(o[0], o[1]); wv.y = cvt_pk_bf16(o[2], o[3]); *(u32x2*)(V + (size_t)row * CWD + c) = wv;
                if (t >= SEQ - 2) *(f32x4*)(o_cp + ((size_t)b * 2 + (t - (SEQ - 2))) * CWD + c) = u2;
                u0 = u1; u1 = u2; }
        }
        for (int b = blockIdx.x; b < NS; b += G) { const int row = NP + b;
            const f32x4 u2 = *(const f32x4*)(U + (size_t)row * CWD + c); const float* sp = state_conv + (size_t)b * 2 * CWD + c; const f32x4 u0 = *(const f32x4*)sp, u1 = *(const f32x4*)(sp + CWD);
            float* op = o_cs + (size_t)b * 2 * CWD + c; *(f32x4*)op = u1; *(f32x4*)(op + CWD) = u2;
            const u32x2 cw = *(const u32x2*)(CB + (size_t)row * CWD + c); f32x4 cb;
            cb[0] = __uint_as_float(cw.x << 16); cb[1] = __uint_as_float(cw.x & 0xffff0000u); cb[2] = __uint_as_float(cw.y << 16); cb[3] = __uint_as_float(cw.y & 0xffff0000u);
            const f32x4 y = bb + u0 * w0 + u1 * w1 + u2 * w2;
            const f32x4 o = cb * y; u32x2 wv; wv.x = cvt_pk_bf16(o[0], o[1]); wv.y = cvt_pk_bf16(o[2], o[3]); *(u32x2*)(V + (size_t)row * CWD + c) = wv; }
    }
}

template <int NBF, class Epi>
__device__ __forceinline__ void skinny_phase(LAS unsigned char* lds, const bf16_t* As, int lda, const bf16_t* Bt, int K, int n_nt, int tsh, int gsh, int foff,
                                             const Epi& E, int bx, int blk_lo, int blk_n, int wid) {
    const int rel = bx - blk_lo; if (rel < 0 || rel >= blk_n) return;
    const int lane = lane_id_v(), fr = lane & 15, fq = lane >> 4;
    const int KS = K >> 3, k_lo = wid * KS, n_units = n_nt * 2;
    LAS f32x4* red = (LAS f32x4*)lds;
    for (int u = rel; u < n_units; u += blk_n) {
        const int mh = u & 1, nt = u >> 1;
        const int rb = ((nt >> tsh) << gsh) + ((nt & ((1 << tsh) - 1)) << 4);
        const bf16_t* ap = As + (size_t)(mh * 64 + fr) * lda + k_lo + fq * 8;
        const bf16_t* bp = Bt + (size_t)(rb + fr) * K + k_lo + fq * 8;
        f32x4 acc[4][NBF];
#pragma unroll
        for (int m = 0; m < 4; ++m)
#pragma unroll
            for (int f = 0; f < NBF; ++f) acc[m][f] = (f32x4){0.f, 0.f, 0.f, 0.f};
#pragma unroll (NBF == 1 ? 8 : 4)
        for (int k = 0; k < KS; k += 32) {
            bf16x8 av[4], bv[NBF];
#pragma unroll
            for (int m = 0; m < 4; ++m) av[m] = *(const bf16x8*)(ap + (size_t)m * 16 * lda + k);
#pragma unroll
            for (int f = 0; f < NBF; ++f) bv[f] = *(const bf16x8*)(bp + (size_t)f * foff * K + k);
#pragma unroll
            for (int m = 0; m < 4; ++m)
#pragma unroll
                for (int f = 0; f < NBF; ++f) acc[m][f] = __builtin_amdgcn_mfma_f32_16x16x32_bf16(bv[f], av[m], acc[m][f], 0, 0, 0);
        }
#pragma unroll
        for (int m = 0; m < 4; ++m)
#pragma unroll
            for (int f = 0; f < NBF; ++f) red[((wid * 4 + m) * NBF + f) * 64 + lane] = acc[m][f];
        __syncthreads();
        if (wid < 4) { f32x4 v[NBF];
#pragma unroll
            for (int f = 0; f < NBF; ++f) { v[f] = red[((0 * 4 + wid) * NBF + f) * 64 + lane];
#pragma unroll
                for (int w = 1; w < 8; ++w) v[f] += red[((w * 4 + wid) * NBF + f) * 64 + lane]; }
            E(mh * 64 + wid * 16 + fr, nt, fq * 4, v); }
        __syncthreads();
    }
}
__device__ __forceinline__ u32x2 pack4(f32x4 o) { u32x2 w; w.x = cvt_pk_bf16(o[0], o[1]); w.y = cvt_pk_bf16(o[2], o[3]); return w; }
__device__ __forceinline__ f32x4 unpack4(u32x2 w) { f32x4 a; a[0] = __uint_as_float(w.x << 16); a[1] = __uint_as_float(w.x & 0xffff0000u); a[2] = __uint_as_float(w.y << 16); a[3] = __uint_as_float(w.y & 0xffff0000u); return a; }
struct SkGU { bf16_t* act;
    __device__ __forceinline__ void operator()(int sr, int nt, int c4, const f32x4* v) const { f32x4 o;
#pragma unroll
        for (int j = 0; j < 4; ++j) o[j] = silu_f(v[0][j]) * v[1][j];
        *(u32x2*)(act + (size_t)(NP + sr) * FF + nt * 16 + c4) = pack4(o); } };
struct SkRes { const float* baseS; float* out; const float* gate; float gs;
    __device__ __forceinline__ void operator()(int sr, int nt, int c4, const f32x4* v) const { const int col = nt * 16 + c4;
        const f32x4 b = *(const f32x4*)(baseS + (size_t)sr * D + col), gg = *(const f32x4*)(gate + (size_t)(NB + sr) * NMOD + col);
        *(f32x4*)(out + (size_t)(NP + sr) * D + col) = b + gs * gg * v[0]; } };
struct SkWinA { float* P; bf16_t* CB;
    __device__ __forceinline__ void operator()(int sr, int nt, int c4, const f32x4* v) const { const int col = nt * 16 + c4;
        if (col < PW) *(f32x4*)(P + (size_t)(NP + sr) * PW + col) = v[0]; else *(u32x2*)(CB + (size_t)(NP + sr) * CWD + col - PW) = pack4(v[0]); } };
struct SkWinU { float* U;
    __device__ __forceinline__ void operator()(int sr, int nt, int c4, const f32x4* v) const { *(f32x4*)(U + (size_t)(NP + sr) * CWD + nt * 16 + c4) = v[0] * v[1]; } };
struct SkWinG { bf16_t* SGA; bf16_t* SGB;
    __device__ __forceinline__ void operator()(int sr, int nt, int c4, const f32x4* v) const { const int col = nt * 16 + c4; f32x4 o;
#pragma unroll
        for (int j = 0; j < 4; ++j) o[j] = sigm_f(v[0][j]);
        if (col < D) *(u32x2*)(SGA + (size_t)(NP + sr) * D + col) = pack4(o); else *(u32x2*)(SGB + (size_t)(NP + sr) * D + col - D) = pack4(o); } };
struct SkGrp { bf16_t* AP; const float* scale; int g;
    __device__ __forceinline__ void operator()(int sr, int nt, int c4, const f32x4* v) const { const int col = g * 256 + nt * 16 + c4;
        *(u32x2*)(AP + (size_t)(NP + sr) * PW + col) = pack4(v[0] * *(const f32x4*)(scale + col)); } };
template <int MODE> struct SkBr { const bf16_t* SG; bf16_t* TA; bf16_t* MO;
    __device__ __forceinline__ void operator()(int sr, int nt, int c4, const f32x4* v) const { const size_t o = (size_t)(NP + sr) * D + nt * 16 + c4;
        f32x4 r = unpack4(*(const u32x2*)(SG + o)) * v[0];
        if (MODE == 1) { r += unpack4(*(const u32x2*)(TA + o)); *(u32x2*)(MO + o) = pack4(r); } else *(u32x2*)(TA + o) = pack4(r); } };

#define XB_TMO      128
#define XB_XCNT(j)  (256  + 64 * (j))
#define XB_XSUB(j)  (1280 + 64 * (j))
#define XB_XGEN(j)  (2304 + 64 * (j))
#define XB_TOP      3328
#define XB_TOPGEN   3392
#define XCD_BAR_WORDS 3456
#define XB_SPIN_CAP (1u << 20)
__device__ __forceinline__ unsigned xb_ld(unsigned* p)              { return __hip_atomic_load(p, __ATOMIC_RELAXED, __HIP_MEMORY_SCOPE_AGENT); }
__device__ __forceinline__ unsigned xb_add(unsigned* p, unsigned v) { return __hip_atomic_fetch_add(p, v, __ATOMIC_RELAXED, __HIP_MEMORY_SCOPE_AGENT); }
__device__ __forceinline__ unsigned xb_xcc_id() { return (unsigned)__builtin_amdgcn_s_getreg((3 << 11) | 20) & 0xFu; }
#define XB_SPIN(cond, bar) do { unsigned _sp = 0; while (cond) { __builtin_amdgcn_s_sleep(1); \
    if ((++_sp & 255u) == 0u) { if (xb_ld(&(bar)[XB_TMO])) break; if (_sp > XB_SPIN_CAP) { atomicAdd(&(bar)[XB_TMO], 1u); break; } } } } while (0)
__device__ __forceinline__ void xcd_barrier_complete(unsigned* bar, unsigned x, unsigned G, unsigned& nloc, unsigned& nx) {
    unsigned sum, cnt, mine, sp = 0u;
    for (;;) {
        sum = 0u; cnt = 0u; mine = 0u;
#pragma unroll
        for (unsigned j = 0; j < 16; ++j) { const unsigned c = xb_ld(&bar[XB_XCNT(j)]); sum += c; cnt += (c > 0u) ? 1u : 0u; mine = (j == x) ? c : mine; }
        if (sum == G) break;
        __builtin_amdgcn_s_sleep(1);
        if ((++sp & 255u) == 0u) { if (xb_ld(&bar[XB_TMO])) break; if (sp > XB_SPIN_CAP) { atomicAdd(&bar[XB_TMO], 1u); break; } }
    }
    nloc = mine > 0u ? mine : 1u; nx = cnt > 0u ? cnt : 1u;
}
__device__ __forceinline__ void grid_barrier(unsigned* bar, volatile LAS unsigned* st, unsigned G, int wid) {
    asm volatile("s_waitcnt vmcnt(0) lgkmcnt(0)" ::: "memory");
    __builtin_amdgcn_s_barrier();
    if (wid == 0 && lane_id_v() == 0) {
        const unsigned x = xb_xcc_id();
        unsigned nloc = st[0], nx = st[1];
        if (nloc == 0u) { xcd_barrier_complete(bar, x, G, nloc, nx); st[0] = nloc; st[1] = nx; }
        const unsigned old = xb_add(&bar[XB_XSUB(x)], 1u);
        const unsigned gen = old / nloc;
        if (old + 1u == (gen + 1u) * nloc) {
            __builtin_amdgcn_fence(__ATOMIC_RELEASE, "agent");
            asm volatile("s_waitcnt vmcnt(0)" ::: "memory");
            const unsigned og = xb_add(&bar[XB_TOP], 1u);
            const unsigned tg = og / nx;
            if (og + 1u == (tg + 1u) * nx) xb_add(&bar[XB_TOPGEN], 1u);
            else XB_SPIN(xb_ld(&bar[XB_TOPGEN]) == tg, bar);
            __builtin_amdgcn_fence(__ATOMIC_ACQUIRE, "agent");
            xb_add(&bar[XB_XGEN(x)], 1u);
            asm volatile("s_waitcnt vmcnt(0)" ::: "memory");
        } else {
            XB_SPIN(xb_ld(&bar[XB_XGEN(x)]) == gen, bar);
            __builtin_amdgcn_fence(__ATOMIC_ACQUIRE, "agent");
            asm volatile("s_waitcnt vmcnt(0)" ::: "memory");
        }
    }
    asm volatile("s_waitcnt vmcnt(0) lgkmcnt(0)" ::: "memory");
    __builtin_amdgcn_s_barrier();
    asm volatile("" ::: "memory");
}

constexpr int N_PHASES = 16;
__global__ void __launch_bounds__(NTHREADS, 2) fwd_kernel(Args a) {
    extern __shared__ __attribute__((aligned(16))) unsigned char lds_raw[];
    LAS unsigned char* lds = (LAS unsigned char*)lds_raw;
    const int G = gridDim.x, bx = blockIdx.x, wid = __builtin_amdgcn_readfirstlane(threadIdx.x >> 6);
    unsigned char* ws = a.ws;
    float* mod = (float*)(ws + WS_MOD); bf16_t* H = (bf16_t*)(ws + WS_H); float* XR = (float*)(ws + WS_XR); bf16_t* ACT = (bf16_t*)(ws + WS_R1);
#if ONE_LAUNCH
    if (wid == 0) { const int l0 = lane_id_v(); if (l0 < 2) ((volatile LAS unsigned*)(lds + 131072))[l0] = 0u; if (l0 == 0) (void)xb_add((unsigned*)(ws + WS_CTL) + XB_XCNT(xb_xcc_id()), 1u); }
    cg::this_grid().sync();
#define SEAM(k) do { STAMP(2 * (k)); if ((k) + 1 < a.ph_hi) grid_barrier((unsigned*)(ws + WS_CTL), (volatile LAS unsigned*)(lds + 131072), (unsigned)G, wid); STAMP(2 * (k) + 1); } while (0)
#else
#define SEAM(k) do { } while (0)
#endif
#define IN(k) (a.ph_lo <= (k) && (k) < a.ph_hi)
#ifdef TS_A
#define STAMP(j) do { if (bx == 0 && wid == 0) { asm volatile("s_waitcnt vmcnt(0)" ::: "memory"); ((volatile unsigned long long*)(ws + WS_TS))[(j)] = __builtin_amdgcn_s_memrealtime(); } } while (0)
#else
#define STAMP(j) do { } while (0)
#endif
#ifdef DBG_STOP
#define DBG_DUMP(k, expr) do { if ((k) == DBG_STOP) { const size_t n_out = (size_t)MR * D + (size_t)NB * 17 * PW + (size_t)NS * 17 * PW; \
        for (size_t i = (size_t)bx * NTHREADS + wid * 64 + lane_id_v(); i < n_out; i += (size_t)G * NTHREADS) a.out[i] = (expr); return; } } while (0)
#else
#define DBG_DUMP(k, expr) do { } while (0)
#endif
    pg8::StaticOrder S;
    STAMP(40);
    if (IN(0)) { p0_prologue(a, lds, G, wid); SEAM(0); }
    if (IN(1)) { pg8::Gemm g{(const bf16_t*)(ws + WS_CS), (const bf16_t*)(ws + WS_R1), D, D, 0}; S.init(1, NMOD / 256, G, bx); EpiMod E{mod, a.in[7]}; pg8::gemm_phase(lds, g, S, E, wid); SEAM(1); DBG_DUMP(1, i < (size_t)256 * NMOD ? mod[i] : 0.f); }
    if (IN(2)) { rowmod_phase(a.in[0], a.in[1], a.in[8], mod, 0, H, G, wid); SEAM(2); }
    const int PT = NP / 256;
    const bf16_t* Hs = H + (size_t)NP * D; const bf16_t* ACTs = ACT + (size_t)NP * FF; float* XRs = XR + (size_t)NP * D;
    const int PLAIN = 30;
    if (IN(3)) { pg8::Gemm g{H, (const bf16_t*)(ws + WS_WGU1), D, D, 0}; S.init(PT, 2 * FF / 256, G, bx, 2 * FF / 256, PT); EpiGU E{ACT}; pg8::gemm_phase(lds, g, S, E, wid); SEAM(3); }
    if (IN(4)) { pg8::Gemm g{ACT, (const bf16_t*)(ws + WS_WD1), FF, FF, 0}; S.init(PT, D / 256, G, bx); EpiRes E{a.in[0], a.in[1], XR, mod + 2 * D, 0.5f}; pg8::gemm_phase(lds, g, S, E, wid);
        SkRes SE{a.in[1], XR, mod + 2 * D, 0.5f}; skinny_phase<1>(lds, ACTs, FF, (const bf16_t*)(ws + WS_WD1), FF, D / 16, PLAIN, 0, 0, SE, bx, 0, G, wid); SEAM(4); }
    if (IN(5)) { rowmod_phase(XR, XR + (size_t)NP * D, a.in[12], mod, 3, H, G, wid); SEAM(5); }
    if (IN(6)) { pg8::Gemm g{H, (const bf16_t*)(ws + WS_WIN), D, D, 0}; S.init(PT, INC / 256, G, bx);
        EpiWin E{(float*)(ws + WS_P), (bf16_t*)(ws + WS_CB), (float*)(ws + WS_U), (bf16_t*)(ws + WS_SGA), (bf16_t*)(ws + WS_SGB)}; pg8::gemm_phase(lds, g, S, E, wid);
        const bf16_t* Win = (const bf16_t*)(ws + WS_WIN);
        SkWinA SA{(float*)(ws + WS_P), (bf16_t*)(ws + WS_CB)}; skinny_phase<1>(lds, Hs, D, Win, D, 2048 / 16, PLAIN, 0, 0, SA, bx, 0, G, wid);
        SkWinU SU{(float*)(ws + WS_U)}; skinny_phase<2>(lds, Hs, D, Win + (size_t)2048 * D, D, 1024 / 16, 3, 8, 128, SU, bx, G / 2, G - G / 2, wid);
        SkWinG SG{(bf16_t*)(ws + WS_SGA), (bf16_t*)(ws + WS_SGB)}; skinny_phase<1>(lds, Hs, D, Win + (size_t)4096 * D, D, 4096 / 16, PLAIN, 0, 0, SG, bx, 0, G, wid); SEAM(6); }
    if (IN(7)) { mixer_phase(a, G, wid); SEAM(7); }
    if (IN(8)) { pg8::Gemm g{(const bf16_t*)(ws + WS_AIN), (const bf16_t*)(ws + WS_WGRP), PW, 256, 256}; S.init(PT, PW / 256, G, bx); EpiGrp E{(bf16_t*)(ws + WS_AP), a.in[15], 0}; pg8::gemm_phase(lds, g, S, E, wid);
        for (int gi = 0; gi < 4; ++gi) { SkGrp SE{(bf16_t*)(ws + WS_AP), a.in[15], gi};
            skinny_phase<1>(lds, (const bf16_t*)(ws + WS_AIN) + (size_t)NP * PW + gi * 256, PW, (const bf16_t*)(ws + WS_WGRP) + (size_t)gi * 65536, 256, 16, PLAIN, 0, 0, SE, bx, G / 2 + gi * (G / 8), G / 8, wid); }
        SEAM(8); }
    if (IN(9)) { pg8::Gemm g{(const bf16_t*)(ws + WS_AP), (const bf16_t*)(ws + WS_WA), PW, PW, 0}; S.init(PT, D / 256, G, bx); EpiBr<0> E{(const bf16_t*)(ws + WS_SGA), (bf16_t*)(ws + WS_TA), nullptr}; pg8::gemm_phase(lds, g, S, E, wid);
        SkBr<0> SE{(const bf16_t*)(ws + WS_SGA), (bf16_t*)(ws + WS_TA), nullptr}; skinny_phase<1>(lds, (const bf16_t*)(ws + WS_AP) + (size_t)NP * PW, PW, (const bf16_t*)(ws + WS_WA), PW, D / 16, PLAIN, 0, 0, SE, bx, 0, G, wid); }
    if (IN(10)) { pg8::Gemm g{(const bf16_t*)(ws + WS_V), (const bf16_t*)(ws + WS_WB), CWD, CWD, 0}; S.init(PT, D / 256, G, bx); EpiBr<1> E{(const bf16_t*)(ws + WS_SGB), (bf16_t*)(ws + WS_TA), H}; pg8::gemm_phase(lds, g, S, E, wid);
        SkBr<1> SE{(const bf16_t*)(ws + WS_SGB), (bf16_t*)(ws + WS_TA), H}; skinny_phase<1>(lds, (const bf16_t*)(ws + WS_V) + (size_t)NP * CWD, CWD, (const bf16_t*)(ws + WS_WB), CWD, D / 16, PLAIN, 0, 0, SE, bx, 0, G, wid); SEAM(10); }
    if (IN(11)) { pg8::Gemm g{H, (const bf16_t*)(ws + WS_WO), D, D, 0}; S.init(PT, D / 256, G, bx); EpiRes E{XR, XRs, XR, mod + 5 * D, 1.0f}; pg8::gemm_phase(lds, g, S, E, wid);
        SkRes SE{XRs, XR, mod + 5 * D, 1.0f}; skinny_phase<1>(lds, Hs, D, (const bf16_t*)(ws + WS_WO), D, D / 16, PLAIN, 0, 0, SE, bx, 0, G, wid); SEAM(11); }
    if (IN(12)) { rowmod_phase(XR, XR + (size_t)NP * D, a.in[21], mod, 6, H, G, wid); SEAM(12); }
    if (IN(13)) { pg8::Gemm g{H, (const bf16_t*)(ws + WS_WGU2), D, D, 0}; S.init(PT, 2 * FF / 256, G, bx, 2 * FF / 256, PT); EpiGU E{ACT}; pg8::gemm_phase(lds, g, S, E, wid); SEAM(13); }
    if (IN(14)) { pg8::Gemm g{ACT, (const bf16_t*)(ws + WS_WD2), FF, FF, 0}; S.init(PT, D / 256, G, bx); EpiRes E{XR, XRs, XR, mod + 8 * D, 0.5f}; pg8::gemm_phase(lds, g, S, E, wid);
        SkRes SE{XRs, XR, mod + 8 * D, 0.5f}; skinny_phase<1>(lds, ACTs, FF, (const bf16_t*)(ws + WS_WD2), FF, D / 16, PLAIN, 0, 0, SE, bx, 0, G, wid); SEAM(14); }
    if (IN(15)) { final_norm_phase(XR, a.in[25], a.out, G, wid); }
#ifdef TS_A
    if (bx == 0 && wid == 0) { asm volatile("s_waitcnt vmcnt(0)" ::: "memory"); volatile unsigned long long* ts = (volatile unsigned long long*)(ws + WS_TS);
        const unsigned long long d = (ts[TS_B] - ts[TS_A]) * TS_F, t0 = __builtin_amdgcn_s_memrealtime();
        while (__builtin_amdgcn_s_memrealtime() - t0 < d) __builtin_amdgcn_s_sleep(8); }
#endif
#undef IN
#undef SEAM
}

extern "C" void kernel_launch(void* const* d_in, const int* in_sizes, int n_in, void* d_out, int out_size, void* d_ws, size_t ws_size, hipStream_t stream) {
    static int grid = 0;
    if (grid == 0) {
        if (n_in != 26 || ws_size < WS_END) { fprintf(stderr, "kernel_launch: unexpected n_in %d / ws %zu (need %zu)\n", n_in, ws_size, (size_t)WS_END); grid = -1; return; }
        int dev = 0, cus = 0, per_cu = 0;
        (void)hipGetDevice(&dev); (void)hipDeviceGetAttribute(&cus, hipDeviceAttributeMultiprocessorCount, dev);
        if (hipFuncSetAttribute((const void*)fwd_kernel, hipFuncAttributeMaxDynamicSharedMemorySize, LDS_BYTES) != hipSuccess) { fprintf(stderr, "kernel_launch: hipFuncSetAttribute failed\n"); grid = -1; return; }
        if (hipOccupancyMaxActiveBlocksPerMultiprocessor(&per_cu, (const void*)fwd_kernel, NTHREADS, LDS_BYTES) != hipSuccess || per_cu < 1) { fprintf(stderr, "kernel_launch: occupancy query gives %d\n", per_cu); per_cu = 1; }
        (void)hipGetLastError();
        grid = cus * 1;
    }
    if (grid < 0) return;
    Args a{};
    for (int i = 0; i < 26; ++i) a.in[i] = (const float*)d_in[i];
    a.out = (float*)d_out; a.ws = (unsigned char*)d_ws;
#if ONE_LAUNCH
    a.ph_lo = 0; a.ph_hi = N_PHASES;
    (void)hipMemsetAsync((unsigned char*)d_ws + WS_CTL, 0, 16384, stream);
    void* args[] = {&a};
    hipError_t e = hipLaunchCooperativeKernel((const void*)fwd_kernel, dim3(grid), dim3(NTHREADS), args, LDS_BYTES, stream);
    if (e != hipSuccess) fprintf(stderr, "cooperative launch failed: %s (grid %d)\n", hipGetErrorString(e), grid);
#else
    for (int ph = 0; ph < N_PHASES; ++ph) { a.ph_lo = ph; a.ph_hi = ph + 1; hipLaunchKernelGGL(fwd_kernel, dim3(grid), dim3(NTHREADS), LDS_BYTES, stream, a); }
#endif
}
```

```cpp
#include <hip/hip_runtime.h>
#include <hip/hip_cooperative_groups.h>
#include <cstdio>
#include <cstdint>
#ifndef ONE_LAUNCH
#define ONE_LAUNCH 1
#endif
namespace cg = cooperative_groups;

#define LAS __attribute__((address_space(3)))
typedef unsigned short bf16_t;
typedef short bf16x8 __attribute__((ext_vector_type(8)));
typedef float f32x4 __attribute__((ext_vector_type(4)));
typedef unsigned u32x4 __attribute__((ext_vector_type(4)));
typedef unsigned u32x2 __attribute__((ext_vector_type(2)));

constexpr int D = 2048, FF = 5632, NP = 8192, NS = 128, MR = NP + NS, MP = 8448, NMT = MP / 256;
constexpr int INC = 8192, PW = 1024, CWD = 1024, NMOD = 9 * D, SEQ = 2048, NB = 4;
constexpr float EPS = 1e-6f;
constexpr int NTHREADS = 512;
constexpr int LDS_BYTES = 131072 + 256;

constexpr size_t al256(size_t x) { return (x + 255) & ~(size_t)255; }
constexpr size_t WS_WGU1 = 0;
constexpr size_t WS_WD1 = WS_WGU1 + (size_t)2 * FF * D * 2;
constexpr size_t WS_WIN = WS_WD1 + (size_t)D * FF * 2;
constexpr size_t WS_WGRP = WS_WIN + (size_t)INC * D * 2;
constexpr size_t WS_WA = WS_WGRP + (size_t)PW * 256 * 2;
constexpr size_t WS_WB = WS_WA + (size_t)D * PW * 2;
constexpr size_t WS_WO = WS_WB + (size_t)D * CWD * 2;
constexpr size_t WS_WGU2 = WS_WO + (size_t)D * D * 2;
constexpr size_t WS_WD2 = WS_WGU2 + (size_t)2 * FF * D * 2;
constexpr size_t WS_MOD = WS_WD2 + (size_t)D * FF * 2;
constexpr size_t WS_CS = WS_MOD + (size_t)256 * NMOD * 4;
constexpr size_t WS_H = WS_CS + (size_t)256 * D * 2;
constexpr size_t WS_XR = WS_H + (size_t)MP * D * 2;
constexpr size_t WS_R1 = WS_XR + (size_t)MP * D * 4;
constexpr size_t R1_BYTES = (size_t)MP * FF * 2;
constexpr size_t WS_P = WS_R1;
constexpr size_t WS_U = WS_P + (size_t)MP * PW * 4;
constexpr size_t WS_CB = WS_U + (size_t)MP * CWD * 4;
static_assert(WS_CB + (size_t)MP * CWD * 2 <= WS_R1 + R1_BYTES, "R1 overlay");
static_assert((size_t)NMOD * D * 2 <= R1_BYTES, "Wada overlay");
constexpr size_t WS_SGA = WS_R1 + R1_BYTES;
constexpr size_t WS_SGB = WS_SGA + (size_t)MP * D * 2;
constexpr size_t WS_AIN = WS_SGB + (size_t)MP * D * 2;
constexpr size_t WS_AP = WS_AIN + (size_t)MP * PW * 2;
constexpr size_t WS_V = WS_AP + (size_t)MP * PW * 2;
constexpr size_t WS_TA = WS_V + (size_t)MP * CWD * 2;
constexpr size_t WS_CTL = WS_TA + (size_t)MP * D * 2;
constexpr size_t WS_TS = WS_CTL + 16384;
constexpr size_t WS_END = WS_TS + 1024;

typedef float f32x2_t __attribute__((ext_vector_type(2)));
typedef __bf16 bf16x2_t __attribute__((ext_vector_type(2)));
__device__ __forceinline__ unsigned cvt_pk_bf16(float lo, float hi) { const f32x2_t v = {lo, hi}; const bf16x2_t b = __builtin_convertvector(v, bf16x2_t); return __builtin_bit_cast(unsigned, b); }
__device__ __forceinline__ u32x4 pack8(f32x4 a, f32x4 b) { u32x4 w; w.x = cvt_pk_bf16(a[0], a[1]); w.y = cvt_pk_bf16(a[2], a[3]); w.z = cvt_pk_bf16(b[0], b[1]); w.w = cvt_pk_bf16(b[2], b[3]); return w; }
__device__ __forceinline__ void unpack8(u32x4 w, f32x4& a, f32x4& b) {
    a[0] = __uint_as_float(w.x << 16); a[1] = __uint_as_float(w.x & 0xffff0000u); a[2] = __uint_as_float(w.y << 16); a[3] = __uint_as_float(w.y & 0xffff0000u);
    b[0] = __uint_as_float(w.z << 16); b[1] = __uint_as_float(w.z & 0xffff0000u); b[2] = __uint_as_float(w.w << 16); b[3] = __uint_as_float(w.w & 0xffff0000u); }
__device__ __forceinline__ float sigm_f(float x) { return __builtin_amdgcn_rcpf(1.0f + __expf(-x)); }
__device__ __forceinline__ float silu_f(float x) { return x * sigm_f(x); }
__device__ __forceinline__ int lane_id_v() { int l; asm volatile("v_mbcnt_lo_u32_b32 %0, -1, 0\n\tv_mbcnt_hi_u32_b32 %0, -1, %0" : "=v"(l)); return l; }
__device__ __forceinline__ int bidx(int row) { return row < NP ? (row >> 11) : (row - NP + NB); }

namespace pg8 {
constexpr int BM = 256, BK = 64, HALF = 128, HTB = HALF * BK * 2, STAGE_BYTES = 8 * HTB, NXCD = 8, WGM = 8;
__host__ __device__ __forceinline__ int lds_byte(int r, int c) { const int st = (r >> 4) * 2 + (c >> 5), rr = r & 15, cc = c & 31, ob = rr * 64 + cc * 2; return st * 1024 + (ob ^ (((ob >> 9) & 1) << 5)); }
__host__ __device__ __forceinline__ void stage_rc(int b, int& R, int& C) { const int st = b / 1024, sb = b % 1024, swz = sb ^ (((sb >> 9) & 1) << 5); R = (st >> 1) * 16 + swz / 64; C = (st & 1) * 32 + (swz % 64) / 2; }
__host__ __device__ __forceinline__ int perm32(int rho) { const int n = rho >> 4, i = rho & 15; return 8 * (i >> 2) + 4 * n + (i & 3); }

struct Unit { int pm, pn; };
struct Gemm { const bf16_t* A; const bf16_t* Bt; int lda, K, a_pn_off; };

struct StaticOrder {
    int nM, nN, nwg, G, c, n_extra, extra_pm;
    __device__ void init(int nM_, int nN_, int G_, int c_, int n_extra_ = 0, int extra_pm_ = 0) { nM = nM_; nN = nN_; nwg = nM * nN; G = G_; c = c_; n_extra = n_extra_; extra_pm = extra_pm_; }
    __device__ bool next(int i, Unit& u) const {
        const long L = (long)i * G + c;
        if (L >= nwg) { if (L >= nwg + n_extra) return false; u.pm = extra_pm; u.pn = (int)(L - nwg); return true; }
        int wgid = (int)L; { const int q = nwg / NXCD, r = nwg % NXCD, xcd = wgid % NXCD, off = wgid / NXCD; wgid = (xcd < r ? xcd * (q + 1) : r * (q + 1) + (xcd - r) * q) + off; }
        const int nig = WGM * nN, gid = wgid / nig, fm = gid * WGM, gsz = (nM - fm) < WGM ? (nM - fm) : WGM;
        u.pm = fm + ((wgid % nig) % gsz); u.pn = (wgid % nig) / gsz; return true;
    }
};

template <class Epi>
__device__ __forceinline__ void gemm_phase(LAS unsigned char* lds, const Gemm g, const StaticOrder& S, const Epi& E, const int wid) {
    const int lane = lane_id_v(), tid = wid * 64 + lane, wr = wid >> 2, wc = wid & 3, fr = lane & 15, fq = lane >> 4;
    const int K = g.K, nt = K / BK, lda = g.lda;
    unsigned voffA[2], voffB[2];
#pragma unroll
    for (int i = 0; i < 2; ++i) { int R, C; stage_rc(tid * 16 + i * 8192, R, C); const int Rb = (R & ~31) + perm32(R & 31);
        voffA[i] = (unsigned)(R * lda + C) * 2u; voffB[i] = (unsigned)(Rb * K + C) * 2u; }
    const size_t kstep = (size_t)(BK * 2);
    const size_t hstepA = (size_t)HALF * lda * 2, tstepA = 2 * hstepA;
    const size_t hstepB = (size_t)HALF * K * 2, tstepB = 2 * hstepB;
    const size_t pnA = (size_t)g.a_pn_off * 2;
    const unsigned ldsw = (unsigned)wid * 1024u;
    const int aoff = lds_byte(wr * 64 + fr, fq * 8), boff = lds_byte(wc * 32 + fr, fq * 8);
#define PG8_SA(b, h) (((b) * 2 + (h)) * HTB)
#define PG8_SB(b, h) ((4 + (b) * 2 + (h)) * HTB)
#define PG8_STAGE(bufoff, gbase, voff) do { _Pragma("unroll") for (int _i = 0; _i < 2; ++_i) \
        __builtin_amdgcn_global_load_lds((const unsigned*)((const char*)(gbase) + (voff)[_i]), (LAS unsigned*)(lds + (bufoff) + ldsw + _i * 8192), 16, 0, 0); } while (0)
#define PG8_LDA(dst, b, h) do { _Pragma("unroll") for (int m = 0; m < 4; ++m) _Pragma("unroll") for (int k = 0; k < 2; ++k) dst[m][k] = *(const LAS bf16x8*)(lds + PG8_SA(b, h) + aoff + m * 2048 + k * 1024); } while (0)
#define PG8_LDB(dst, b, h) do { _Pragma("unroll") for (int n = 0; n < 2; ++n) _Pragma("unroll") for (int k = 0; k < 2; ++k) dst[n][k] = *(const LAS bf16x8*)(lds + PG8_SB(b, h) + boff + n * 2048 + k * 1024); } while (0)
#define PG8_MMA(ai, bj, At, Bt) do { __builtin_amdgcn_s_setprio(1); _Pragma("unroll") for (int m = 0; m < 4; ++m) _Pragma("unroll") for (int n = 0; n < 2; ++n) _Pragma("unroll") for (int k = 0; k < 2; ++k) \
        acc[ai][bj][m][n] = __builtin_amdgcn_mfma_f32_16x16x32_bf16(Bt[n][k], At[m][k], acc[ai][bj][m][n], 0, 0, 0); __builtin_amdgcn_s_setprio(0); } while (0)
#define PG8_WAIT_V(n) asm volatile("s_waitcnt vmcnt(" #n ")" ::: "memory")
#define PG8_WAIT_L(n) asm volatile("s_waitcnt lgkmcnt(" #n ")" ::: "memory")
#define PG8_BAR __builtin_amdgcn_s_barrier()
#define PG8_SCHED __builtin_amdgcn_sched_barrier(0)
    Unit cur, nxt; int ui = 0;
    if (!S.next(0, cur)) return;
    f32x4 acc[2][2][4][2];
#pragma unroll
    for (int a = 0; a < 2; ++a)
#pragma unroll
        for (int b = 0; b < 2; ++b)
#pragma unroll
            for (int m = 0; m < 4; ++m)
#pragma unroll
                for (int n = 0; n < 2; ++n) acc[a][b][m][n] = (f32x4){0.f, 0.f, 0.f, 0.f};
    bf16x8 At[4][2], B0[2][2], B1[2][2];
    const char* cA = (const char*)g.A + (size_t)cur.pm * tstepA + (size_t)cur.pn * pnA; const char* cB = (const char*)g.Bt + (size_t)cur.pn * tstepB;
    PG8_STAGE(PG8_SB(0, 0), cB, voffB); PG8_STAGE(PG8_SB(0, 1), cB + hstepB, voffB); PG8_STAGE(PG8_SA(0, 0), cA, voffA); PG8_STAGE(PG8_SA(0, 1), cA + hstepA, voffA);
    if (wr == 1) PG8_BAR;
    PG8_WAIT_V(2); PG8_BAR;
    PG8_STAGE(PG8_SB(1, 0), cB + kstep, voffB); PG8_STAGE(PG8_SA(1, 0), cA + kstep, voffA); PG8_STAGE(PG8_SB(1, 1), cB + hstepB + kstep, voffB);
    PG8_WAIT_V(6); PG8_BAR;
    for (;;) {
        const bool has_next = S.next(ui + 1, nxt);
        const char* nA = has_next ? (const char*)g.A + (size_t)nxt.pm * tstepA + (size_t)nxt.pn * pnA : cA; const char* nB = has_next ? (const char*)g.Bt + (size_t)nxt.pn * tstepB : cB;
#pragma clang loop unroll(disable)
        for (int t = 0; t < nt; t += 2) {
            const bool last = (t == nt - 2);
            const char* a1 = cA + (size_t)(t + 1) * kstep;
            const char* a2 = last ? nA : cA + (size_t)(t + 2) * kstep; const char* b2 = last ? nB : cB + (size_t)(t + 2) * kstep;
            const char* a3 = a2 + kstep; const char* b3 = b2 + kstep;
            PG8_LDB(B0, 0, 0); PG8_LDB(B1, 0, 1); PG8_SCHED; PG8_LDA(At, 0, 0); PG8_STAGE(PG8_SA(1, 1), a1 + hstepA, voffA);
            PG8_WAIT_V(8); PG8_WAIT_L(0); PG8_BAR; PG8_MMA(0, 0, At, B0); PG8_MMA(0, 1, At, B1); PG8_BAR; PG8_SCHED;
            PG8_LDA(At, 0, 1); PG8_STAGE(PG8_SB(0, 0), b2, voffB); PG8_STAGE(PG8_SB(0, 1), b2 + hstepB, voffB); PG8_STAGE(PG8_SA(0, 0), a2, voffA);
            PG8_WAIT_V(8); PG8_WAIT_L(0); PG8_BAR; PG8_MMA(1, 0, At, B0); PG8_MMA(1, 1, At, B1); PG8_BAR; PG8_SCHED;
            PG8_LDB(B0, 1, 0); PG8_LDB(B1, 1, 1); PG8_SCHED; PG8_LDA(At, 1, 0); PG8_STAGE(PG8_SA(0, 1), a2 + hstepA, voffA);
            PG8_WAIT_V(8); PG8_WAIT_L(0); PG8_BAR; PG8_MMA(0, 0, At, B0); PG8_MMA(0, 1, At, B1); PG8_BAR; PG8_SCHED;
            PG8_LDA(At, 1, 1); PG8_STAGE(PG8_SB(1, 0), b3, voffB); PG8_STAGE(PG8_SB(1, 1), b3 + hstepB, voffB); PG8_STAGE(PG8_SA(1, 0), a3, voffA);
            PG8_WAIT_V(8); PG8_WAIT_L(0); PG8_BAR; PG8_MMA(1, 0, At, B0); PG8_MMA(1, 1, At, B1); PG8_BAR; PG8_SCHED;
        }
        if (wr == 0) PG8_BAR;
        { const int el = lane_id_v(); E(acc, cur, wr, wc, el & 15, el >> 4); }
        if (!has_next) break;
#pragma unroll
        for (int a = 0; a < 2; ++a)
#pragma unroll
            for (int b = 0; b < 2; ++b)
#pragma unroll
                for (int m = 0; m < 4; ++m)
#pragma unroll
                    for (int n = 0; n < 2; ++n) acc[a][b][m][n] = (f32x4){0.f, 0.f, 0.f, 0.f};
        cur = nxt; cA = nA; cB = nB; ++ui;
        if (wr == 1) PG8_BAR;
    }
    PG8_WAIT_V(0);
    PG8_BAR;
#undef PG8_SA
#undef PG8_SB
#undef PG8_STAGE
#undef PG8_LDA
#undef PG8_LDB
#undef PG8_MMA
#undef PG8_WAIT_V
#undef PG8_WAIT_L
#undef PG8_BAR
#undef PG8_SCHED
}
}

using pg8::Unit;
typedef f32x4 AccT[2][2][4][2];
#define EPI_ROW(u, ai, m) ((u).pm * 256 + (ai) * 128 + wr * 64 + (m) * 16 + fr)
#define EPI_COL(u, bj) ((u).pn * 256 + (bj) * 128 + wc * 32 + fq * 8)

struct EpiMod {
    float* mod; const float* bias;
    __device__ __forceinline__ void operator()(const AccT& acc, const Unit& u, int wr, int wc, int fr, int fq) const {
#pragma unroll
        for (int bj = 0; bj < 2; ++bj) { const int col = EPI_COL(u, bj); const f32x4 b0 = *(const f32x4*)(bias + col), b1 = *(const f32x4*)(bias + col + 4);
#pragma unroll
            for (int ai = 0; ai < 2; ++ai)
#pragma unroll
                for (int m = 0; m < 4; ++m) { float* p = mod + (size_t)EPI_ROW(u, ai, m) * NMOD + col; *(f32x4*)p = acc[ai][bj][m][0] + b0; *(f32x4*)(p + 4) = acc[ai][bj][m][1] + b1; } }
    }
};
struct EpiGU {
    bf16_t* act;
    __device__ __forceinline__ void operator()(const AccT& acc, const Unit& u, int wr, int wc, int fr, int fq) const {
#pragma unroll
        for (int ai = 0; ai < 2; ++ai)
#pragma unroll
            for (int m = 0; m < 4; ++m) { f32x4 o[2];
#pragma unroll
                for (int n = 0; n < 2; ++n)
#pragma unroll
                    for (int j = 0; j < 4; ++j) o[n][j] = silu_f(acc[ai][0][m][n][j]) * acc[ai][1][m][n][j];
                *(u32x4*)(act + (size_t)EPI_ROW(u, ai, m) * FF + u.pn * 128 + wc * 32 + fq * 8) = pack8(o[0], o[1]); }
    }
};
struct EpiRes {
    const float* baseP; const float* baseS; float* out; const float* gate; float gs;
    __device__ __forceinline__ void operator()(const AccT& acc, const Unit& u, int wr, int wc, int fr, int fq) const {
#pragma unroll
        for (int ai = 0; ai < 2; ++ai)
#pragma unroll
            for (int m = 0; m < 4; ++m) { const int row = EPI_ROW(u, ai, m);
                if (row < MR) { const float* bp = row < NP ? baseP + (size_t)row * D : baseS + (size_t)(row - NP) * D; const float* gp = gate + (size_t)bidx(row) * NMOD; float* op = out + (size_t)row * D;
#pragma unroll
                    for (int bj = 0; bj < 2; ++bj) { const int col = EPI_COL(u, bj);
#pragma unroll
                        for (int n = 0; n < 2; ++n) { const f32x4 b = *(const f32x4*)(bp + col + 4 * n), gg = *(const f32x4*)(gp + col + 4 * n); *(f32x4*)(op + col + 4 * n) = b + gs * gg * acc[ai][bj][m][n]; } } }
                asm volatile("" ::: "memory"); }
    }
};
struct EpiWin {
    float* P; bf16_t* CB; float* U; bf16_t* SGA; bf16_t* SGB;
    __device__ __forceinline__ void operator()(const AccT& acc, const Unit& u, int wr, int wc, int fr, int fq) const {
        const int pn = u.pn;
        if (pn < 4) {
#pragma unroll
            for (int ai = 0; ai < 2; ++ai)
#pragma unroll
                for (int m = 0; m < 4; ++m) { float* p = P + (size_t)EPI_ROW(u, ai, m) * PW;
#pragma unroll
                    for (int bj = 0; bj < 2; ++bj) { const int col = EPI_COL(u, bj); *(f32x4*)(p + col) = acc[ai][bj][m][0]; *(f32x4*)(p + col + 4) = acc[ai][bj][m][1]; } }
        } else if (pn < 8) {
#pragma unroll
            for (int ai = 0; ai < 2; ++ai)
#pragma unroll
                for (int m = 0; m < 4; ++m) { bf16_t* p = CB + (size_t)EPI_ROW(u, ai, m) * CWD - 1024;
#pragma unroll
                    for (int bj = 0; bj < 2; ++bj) *(u32x4*)(p + EPI_COL(u, bj)) = pack8(acc[ai][bj][m][0], acc[ai][bj][m][1]); }
        } else if (pn < 16) {
#pragma unroll
            for (int ai = 0; ai < 2; ++ai)
#pragma unroll
                for (int m = 0; m < 4; ++m) { float* p = U + (size_t)EPI_ROW(u, ai, m) * CWD + (pn - 8) * 128 + wc * 32 + fq * 8;
                    *(f32x4*)p = acc[ai][0][m][0] * acc[ai][1][m][0]; *(f32x4*)(p + 4) = acc[ai][0][m][1] * acc[ai][1][m][1]; }
        } else {
            bf16_t* base = pn < 24 ? SGA - 4096 : SGB - 6144;
#pragma unroll
            for (int ai = 0; ai < 2; ++ai)
#pragma unroll
                for (int m = 0; m < 4; ++m) { bf16_t* p = base + (size_t)EPI_ROW(u, ai, m) * D;
#pragma unroll
                    for (int bj = 0; bj < 2; ++bj) { f32x4 o[2];
#pragma unroll
                        for (int n = 0; n < 2; ++n)
#pragma unroll
                            for (int j = 0; j < 4; ++j) o[n][j] = sigm_f(acc[ai][bj][m][n][j]);
                        *(u32x4*)(p + EPI_COL(u, bj)) = pack8(o[0], o[1]); } }
        }
    }
};
struct EpiGrp {
    bf16_t* AP; const float* scale; int coff;
    __device__ __forceinline__ void operator()(const AccT& acc, const Unit& u, int wr, int wc, int fr, int fq) const {
#pragma unroll
        for (int bj = 0; bj < 2; ++bj) { const int col = coff + EPI_COL(u, bj); const f32x4 s0 = *(const f32x4*)(scale + col), s1 = *(const f32x4*)(scale + col + 4);
#pragma unroll
            for (int ai = 0; ai < 2; ++ai)
#pragma unroll
                for (int m = 0; m < 4; ++m) *(u32x4*)(AP + (size_t)EPI_ROW(u, ai, m) * PW + col) = pack8(acc[ai][bj][m][0] * s0, acc[ai][bj][m][1] * s1); }
    }
};
template <int MODE> struct EpiBr {
    const bf16_t* SG; bf16_t* TA; bf16_t* MO;
    __device__ __forceinline__ void operator()(const AccT& acc, const Unit& u, int wr, int wc, int fr, int fq) const {
#pragma unroll
        for (int ai = 0; ai < 2; ++ai)
#pragma unroll
            for (int m = 0; m < 4; ++m) { const size_t ro = (size_t)EPI_ROW(u, ai, m) * D;
#pragma unroll
                for (int bj = 0; bj < 2; ++bj) { const size_t o = ro + EPI_COL(u, bj); f32x4 s0, s1; unpack8(*(const u32x4*)(SG + o), s0, s1);
                    f32x4 r0 = s0 * acc[ai][bj][m][0], r1 = s1 * acc[ai][bj][m][1];
                    if (MODE == 1) { f32x4 t0, t1; unpack8(*(const u32x4*)(TA + o), t0, t1); r0 += t0; r1 += t1; *(u32x4*)(MO + o) = pack8(r0, r1); }
                    else *(u32x4*)(TA + o) = pack8(r0, r1); }
                asm volatile("" ::: "memory"); }
    }
};

struct Args { const float* in[26]; float* out; unsigned char* ws; int ph_lo, ph_hi; };

__device__ __forceinline__ int map_row(int map, int n) {
    if (map == 1) return (n >> 7) * 256 + (n & 127);
    if (map == 2) return (n >> 7) * 256 + 128 + (n & 127);
    if (map == 3) { if (n < 2048 || n >= 4096) return n; if (n < 3072) { const int j = n - 2048; return 2048 + (j >> 7) * 256 + (j & 127); } const int j = n - 3072; return 2048 + (j >> 7) * 256 + 128 + (j & 127); }
    return n;
}
__device__ void cvt_task(LAS unsigned* T0, const float* src, bf16_t* dst, int K, int N, int dstK, int map, int& base, int blk_lo, int blk_n, int tid, int& par) {
    const int tn = N / 64, ntiles = (K / 128) * tn;
    const int nq = tid & 15, kp = tid >> 4;
    const int rel = (int)blockIdx.x - blk_lo, G = blk_n;
    const int first = (rel - base % G + G) % G;
    base += ntiles;
    if (rel < 0 || rel >= blk_n || first >= ntiles) return;
    f32x4 r[2][2], rn[2][2];
    { const int kt = first / tn, ntile = first - kt * tn, k0 = kt * 128, n0 = ntile * 64;
#pragma unroll
      for (int it = 0; it < 2; ++it) { const int k = k0 + 2 * (kp + 32 * it); r[it][0] = *(const f32x4*)(src + (size_t)k * N + n0 + nq * 4); r[it][1] = *(const f32x4*)(src + (size_t)(k + 1) * N + n0 + nq * 4); } }
    for (int t = first; t < ntiles; t += G) {
        const int kt = t / tn, ntile = t - kt * tn, k0 = kt * 128, n0 = ntile * 64;
        const int t2 = t + G;
        if (t2 < ntiles) { const int kt2 = t2 / tn, ntile2 = t2 - kt2 * tn, k02 = kt2 * 128, n02 = ntile2 * 64;
#pragma unroll
            for (int it = 0; it < 2; ++it) { const int k = k02 + 2 * (kp + 32 * it); rn[it][0] = *(const f32x4*)(src + (size_t)k * N + n02 + nq * 4); rn[it][1] = *(const f32x4*)(src + (size_t)(k + 1) * N + n02 + nq * 4); } }
        LAS unsigned* T = T0 + par * (64 * 65); par ^= 1;
#pragma unroll
        for (int it = 0; it < 2; ++it) { const int kk = kp + 32 * it;
#pragma unroll
            for (int j = 0; j < 4; ++j) T[(nq * 4 + j) * 65 + kk] = cvt_pk_bf16(r[it][0][j], r[it][1][j]); }
        __syncthreads();
        const int n0d = map_row(map, n0);
#pragma unroll
        for (int ps = 0; ps < 2; ++ps) { const int nl = (tid >> 4) + 32 * ps, kq = tid & 15; u32x4 w;
            w.x = T[nl * 65 + kq * 4 + 0]; w.y = T[nl * 65 + kq * 4 + 1]; w.z = T[nl * 65 + kq * 4 + 2]; w.w = T[nl * 65 + kq * 4 + 3];
            *(u32x4*)(dst + (size_t)(n0d + nl) * dstK + k0 + kq * 8) = w; }
#pragma unroll
        for (int it = 0; it < 2; ++it) { r[it][0] = rn[it][0]; r[it][1] = rn[it][1]; }
    }
}

__device__ void p0a_prologue(const Args& a, LAS unsigned char* lds, int G, int wid) {
    const int tid = wid * 64 + lane_id_v();
    unsigned char* ws = a.ws; LAS unsigned* T = (LAS unsigned*)lds; int base = 0, par = 0;
    cvt_task(T, a.in[6], (bf16_t*)(ws + WS_R1), D, NMOD, D, 0, base, 0, G, tid, par);
    bf16_t* cs = (bf16_t*)(ws + WS_CS);
    for (int i = blockIdx.x * NTHREADS + tid; i < 256 * D / 4; i += G * NTHREADS) { const int row = i / (D / 4), c4 = (i - row * (D / 4)) * 4; u32x2 w = {0u, 0u};
        if (row < NB + NS) { const float* cp = row < NB ? a.in[2] + (size_t)row * D : a.in[3] + (size_t)(row - NB) * D; const f32x4 v = *(const f32x4*)(cp + c4);
            w.x = cvt_pk_bf16(silu_f(v[0]), silu_f(v[1])); w.y = cvt_pk_bf16(silu_f(v[2]), silu_f(v[3])); }
        *(u32x2*)(cs + (size_t)row * D + c4) = w; }
}
__device__ void p0b_prologue(const Args& a, LAS unsigned char* lds, int G, int wid, int lo) {
    const int tid = wid * 64 + lane_id_v();
    unsigned char* ws = a.ws; LAS unsigned* T = (LAS unsigned*)lds; int base = 0, par = 0;
    cvt_task(T, a.in[9], (bf16_t*)(ws + WS_WGU1), D, FF, D, 1, base, lo, G - lo, tid, par);
    cvt_task(T, a.in[10], (bf16_t*)(ws + WS_WGU1), D, FF, D, 2, base, lo, G - lo, tid, par);
    cvt_task(T, a.in[11], (bf16_t*)(ws + WS_WD1), FF, D, FF, 0, base, lo, G - lo, tid, par);
    base = 0;
    cvt_task(T, a.in[13], (bf16_t*)(ws + WS_WIN), D, INC, D, 3, base, 0, G, tid, par);
    for (int g = 0; g < 4; ++g) cvt_task(T, a.in[14] + (size_t)g * 65536, (bf16_t*)(ws + WS_WGRP) + (size_t)g * 65536, 256, 256, 256, 0, base, 0, G, tid, par);
    cvt_task(T, a.in[16], (bf16_t*)(ws + WS_WA), PW, D, PW, 0, base, 0, G, tid, par);
    cvt_task(T, a.in[19], (bf16_t*)(ws + WS_WB), CWD, D, CWD, 0, base, 0, G, tid, par);
    cvt_task(T, a.in[20], (bf16_t*)(ws + WS_WO), D, D, D, 0, base, 0, G, tid, par);
}

__device__ void late_cvt(const Args& a, LAS unsigned char* lds, int G, int wid, int lo, int which) {
    const int tid = wid * 64 + lane_id_v();
    unsigned char* ws = a.ws; LAS unsigned* T = (LAS unsigned*)lds; int base = 0, par = 0;
    if (which == 0) { cvt_task(T, a.in[22], (bf16_t*)(ws + WS_WGU2), D, FF, D, 1, base, lo, G - lo, tid, par); cvt_task(T, a.in[23], (bf16_t*)(ws + WS_WGU2), D, FF, D, 2, base, lo, G - lo, tid, par); }
    else cvt_task(T, a.in[24], (bf16_t*)(ws + WS_WD2), FF, D, FF, 0, base, lo, G - lo, tid, par);
}
__device__ __forceinline__ float wave_sum(float s) {
#pragma unroll
    for (int o = 32; o >= 1; o >>= 1) s += __shfl_xor(s, o);
    return s;
}
__device__ void rowmod_phase(const float* srcP, const float* srcS, const float* normw, const float* mod, int jsh, bf16_t* h, int G, int wid) {
    const int lane = lane_id_v();
    for (int row = blockIdx.x * 8 + wid; row < MR; row += G * 8) {
        const float* src = row < NP ? srcP + (size_t)row * D : srcS + (size_t)(row - NP) * D;
        const float* sh = mod + (size_t)bidx(row) * NMOD + (size_t)jsh * D; const float* sc = sh + D;
        f32x4 v[8]; float ss = 0.f;
#pragma unroll
        for (int i = 0; i < 8; ++i) { v[i] = *(const f32x4*)(src + (i * 64 + lane) * 4); ss += v[i][0] * v[i][0] + v[i][1] * v[i][1] + v[i][2] * v[i][2] + v[i][3] * v[i][3]; }
        ss = wave_sum(ss); const float inv = rsqrtf(ss * (1.0f / D) + EPS);
#pragma unroll
        for (int i = 0; i < 8; ++i) { const int c = (i * 64 + lane) * 4; const f32x4 g4 = *(const f32x4*)(normw + c), s4 = *(const f32x4*)(sc + c), h4 = *(const f32x4*)(sh + c);
            const f32x4 o = (v[i] * inv) * g4 * (1.0f + s4) + h4; u32x2 w; w.x = cvt_pk_bf16(o[0], o[1]); w.y = cvt_pk_bf16(o[2], o[3]); *(u32x2*)(h + (size_t)row * D + c) = w; }
    }
}
__device__ void final_norm_phase(const float* xr, const float* normw, float* out, int G, int wid) {
    const int lane = lane_id_v();
    for (int row = blockIdx.x * 8 + wid; row < MR; row += G * 8) {
        const float* src = xr + (size_t)row * D; f32x4 v[8]; float ss = 0.f;
#pragma unroll
        for (int i = 0; i < 8; ++i) { v[i] = *(const f32x4*)(src + (i * 64 + lane) * 4); ss += v[i][0] * v[i][0] + v[i][1] * v[i][1] + v[i][2] * v[i][2] + v[i][3] * v[i][3]; }
        ss = wave_sum(ss); const float inv = rsqrtf(ss * (1.0f / D) + EPS);
#pragma unroll
        for (int i = 0; i < 8; ++i) { const int c = (i * 64 + lane) * 4; *(f32x4*)(out + (size_t)row * D + c) = (v[i] * inv) * *(const f32x4*)(normw + c); }
    }
}
__device__ void mixer_phase(const Args& a, int G, int wid) {
    unsigned char* ws = a.ws;
    const float* P = (const float*)(ws + WS_P); const float* U = (const float*)(ws + WS_U); const bf16_t* CB = (const bf16_t*)(ws + WS_CB);
    bf16_t* AIN = (bf16_t*)(ws + WS_AIN); bf16_t* V = (bf16_t*)(ws + WS_V);
    const float* state_pool = a.in[4]; const float* state_conv = a.in[5]; const float* conv_w = a.in[17]; const float* conv_b = a.in[18];
    float* o_pp = a.out + (size_t)MR * D; float* o_cp = o_pp + (size_t)NB * 15 * PW; float* o_cs; float* o_ps = o_cp + (size_t)NB * 2 * CWD; o_cs = o_ps + (size_t)NS * 15 * PW;
    const int tid = wid * 64 + lane_id_v();
    const f32x4 z4 = {0.f, 0.f, 0.f, 0.f};
    if (wid < 4) {
        const int c = tid * 4, g = tid >> 6, w = 2 << g;
        for (int ch = blockIdx.x; ch < NP / 32; ch += G) {
            const int r0 = ch * 32, b = r0 >> 11, t0 = r0 & (SEQ - 1);
            f32x4 s = z4;
            for (int i = 1; i < w; ++i) if (t0 - i >= 0) s += *(const f32x4*)(P + (size_t)(r0 - i) * PW + c);
#pragma unroll 4
            for (int j = 0; j < 32; ++j) { const int row = r0 + j, t = t0 + j;
                const f32x4 pc = *(const f32x4*)(P + (size_t)row * PW + c);
                f32x4 old = z4; if (t - (w - 1) >= 0) old = *(const f32x4*)(P + (size_t)(row - (w - 1)) * PW + c);
                s += pc; const int cnt = (t + 1) < w ? (t + 1) : w;
                const f32x4 o = s * (1.0f / (float)cnt) - pc; u32x2 wv; wv.x = cvt_pk_bf16(o[0], o[1]); wv.y = cvt_pk_bf16(o[2], o[3]); *(u32x2*)(AIN + (size_t)row * PW + c) = wv;
                if (t >= SEQ - 15) *(f32x4*)(o_pp + ((size_t)b * 15 + (t - (SEQ - 15))) * PW + c) = pc;
                s -= old; }
        }
        for (int b = blockIdx.x; b < NS; b += G) { const int row = NP + b;
            const f32x4 pc = *(const f32x4*)(P + (size_t)row * PW + c); f32x4 s = pc; const float* sp = state_pool + (size_t)b * 15 * PW + c;
            for (int i = 1; i < w; ++i) s += *(const f32x4*)(sp + (size_t)(15 - i) * PW);
            float* op = o_ps + (size_t)b * 15 * PW + c;
#pragma unroll
            for (int i = 0; i < 14; ++i) *(f32x4*)(op + (size_t)i * PW) = *(const f32x4*)(sp + (size_t)(i + 1) * PW);
            *(f32x4*)(op + (size_t)14 * PW) = pc;
            const f32x4 o = s * (1.0f / (float)w) - pc; u32x2 wv; wv.x = cvt_pk_bf16(o[0], o[1]); wv.y = cvt_pk_bf16(o[2], o[3]); *(u32x2*)(AIN + (size_t)row * PW + c) = wv; }
    } else {
        const int c = (tid - 256) * 4;
        const f32x4 w0 = *(const f32x4*)(conv_w + c), w1 = *(const f32x4*)(conv_w + CWD + c), w2 = *(const f32x4*)(conv_w + 2 * CWD + c), bb = *(const f32x4*)(conv_b + c);
        for (int ch = blockIdx.x; ch < NP / 32; ch += G) {
            const int r0 = ch * 32, b = r0 >> 11, t0 = r0 & (SEQ - 1);
            f32x4 u0 = z4, u1 = z4;
            if (t0 > 0) { u0 = *(const f32x4*)(U + (size_t)(r0 - 2) * CWD + c); u1 = *(const f32x4*)(U + (size_t)(r0 - 1) * CWD + c); }
#pragma unroll 4
            for (int j = 0; j < 32; ++j) { const int row = r0 + j, t = t0 + j;
                const f32x4 u2 = *(const f32x4*)(U + (size_t)row * CWD + c);
                const u32x2 cw = *(const u32x2*)(CB + (size_t)row * CWD + c); f32x4 cb;
                cb[0] = __uint_as_float(cw.x << 16); cb[1] = __uint_as_float(cw.x & 0xffff0000u); cb[2] = __uint_as_float(cw.y << 16); cb[3] = __uint_as_float(cw.y & 0xffff0000u);
                const f32x4 y = bb + u0 * w0 + u1 * w1 + u2 * w2;
                const f32x4 o = cb * y; u32x2 wv; wv.x = cvt_pk_bf16(o[0], o[1]); wv.y = cvt_pk_bf16(o[2], o[3]); *(u32x2*)(V + (size_t)row * CWD + c) = wv;
                if (t >= SEQ - 2) *(f32x4*)(o_cp + ((size_t)b * 2 + (t - (SEQ - 2))) * CWD + c) = u2;
                u0 = u1; u1 = u2; }
        }
        for (int b = blockIdx.x; b < NS; b += G) { const int row = NP + b;
            const f32x4 u2 = *(const f32x4*)(U + (size_t)row * CWD + c); const float* sp = state_conv + (size_t)b * 2 * CWD + c; const f32x4 u0 = *(const f32x4*)sp, u1 = *(const f32x4*)(sp + CWD);
            float* op = o_cs + (size_t)b * 2 * CWD + c; *(f32x4*)op = u1; *(f32x4*)(op + CWD) = u2;
            const u32x2 cw = *(const u32x2*)(CB + (size_t)row * CWD + c); f32x4 cb;
            cb[0] = __uint_as_float(cw.x << 16); cb[1] = __uint_as_float(cw.x & 0xffff0000u); cb[2] = __uint_as_float(cw.y << 16); cb[3] = __uint_as_float(cw.y & 0xffff0000u);
            const f32x4 y = bb + u0 * w0 + u1 * w1 + u2 * w2;
            const f32x4 o = cb * y; u32x2 wv; wv.x = cvt_pk_bf16(o[0], o[1]); wv.y = cvt_pk_bf16(o[2], o[3]); *(u32x2*)(V + (size_t)row * CWD + c) = wv; }
    }
}

template <int NBF, class Epi>
__device__ __forceinline__ void skinny_phase(LAS unsigned char* lds, const bf16_t* As, int lda, const bf16_t* Bt, int K, int n_nt, int tsh, int gsh, int foff,
                                             const Epi& E, int bx, int blk_lo, int blk_n, int wid) {
    const int rel = bx - blk_lo; if (rel < 0 || rel >= blk_n) return;
    const int lane = lane_id_v(), fr = lane & 15, fq = lane >> 4;
    const int KS = K >> 3, k_lo = wid * KS, n_units = n_nt * 2;
    LAS f32x4* red = (LAS f32x4*)lds;
    for (int u = rel; u < n_units; u += blk_n) {
        const int mh = u & 1, nt = u >> 1;
        const int rb = ((nt >> tsh) << gsh) + ((nt & ((1 << tsh) - 1)) << 4);
        const bf16_t* ap = As + (size_t)(mh * 64 + fr) * lda + k_lo + fq * 8;
        const bf16_t* bp = Bt + (size_t)(rb + fr) * K + k_lo + fq * 8;
        f32x4 acc[4][NBF];
#pragma unroll
        for (int m = 0; m < 4; ++m)
#pragma unroll
            for (int f = 0; f < NBF; ++f) acc[m][f] = (f32x4){0.f, 0.f, 0.f, 0.f};
#pragma unroll (NBF == 1 ? 8 : 4)
        for (int k = 0; k < KS; k += 32) {
            bf16x8 av[4], bv[NBF];
#pragma unroll
            for (int m = 0; m < 4; ++m) av[m] = *(const bf16x8*)(ap + (size_t)m * 16 * lda + k);
#pragma unroll
            for (int f = 0; f < NBF; ++f) bv[f] = *(const bf16x8*)(bp + (size_t)f * foff * K + k);
#pragma unroll
            for (int m = 0; m < 4; ++m)
#pragma unroll
                for (int f = 0; f < NBF; ++f) acc[m][f] = __builtin_amdgcn_mfma_f32_16x16x32_bf16(bv[f], av[m], acc[m][f], 0, 0, 0);
        }
#pragma unroll
        for (int m = 0; m < 4; ++m)
#pragma unroll
            for (int f = 0; f < NBF; ++f) red[((wid * 4 + m) * NBF + f) * 64 + lane] = acc[m][f];
        __syncthreads();
        if (wid < 4) { f32x4 v[NBF];
#pragma unroll
            for (int f = 0; f < NBF; ++f) { v[f] = red[((0 * 4 + wid) * NBF + f) * 64 + lane];
#pragma unroll
                for (int w = 1; w < 8; ++w) v[f] += red[((w * 4 + wid) * NBF + f) * 64 + lane]; }
            E(mh * 64 + wid * 16 + fr, nt, fq * 4, v); }
        __syncthreads();
    }
}
__device__ __forceinline__ u32x2 pack4(f32x4 o) { u32x2 w; w.x = cvt_pk_bf16(o[0], o[1]); w.y = cvt_pk_bf16(o[2], o[3]); return w; }
__device__ __forceinline__ f32x4 unpack4(u32x2 w) { f32x4 a; a[0] = __uint_as_float(w.x << 16); a[1] = __uint_as_float(w.x & 0xffff0000u); a[2] = __uint_as_float(w.y << 16); a[3] = __uint_as_float(w.y & 0xffff0000u); return a; }
struct SkGU { bf16_t* act;
    __device__ __forceinline__ void operator()(int sr, int nt, int c4, const f32x4* v) const { f32x4 o;
#pragma unroll
        for (int j = 0; j < 4; ++j) o[j] = silu_f(v[0][j]) * v[1][j];
        *(u32x2*)(act + (size_t)(NP + sr) * FF + nt * 16 + c4) = pack4(o); } };
struct SkRes { const float* baseS; float* out; const float* gate; float gs;
    __device__ __forceinline__ void operator()(int sr, int nt, int c4, const f32x4* v) const { const int col = nt * 16 + c4;
        const f32x4 b = *(const f32x4*)(baseS + (size_t)sr * D + col), gg = *(const f32x4*)(gate + (size_t)(NB + sr) * NMOD + col);
        *(f32x4*)(out + (size_t)(NP + sr) * D + col) = b + gs * gg * v[0]; } };
struct SkWinA { float* P; bf16_t* CB;
    __device__ __forceinline__ void operator()(int sr, int nt, int c4, const f32x4* v) const { const int col = nt * 16 + c4;
        if (col < PW) *(f32x4*)(P + (size_t)(NP + sr) * PW + col) = v[0]; else *(u32x2*)(CB + (size_t)(NP + sr) * CWD + col - PW) = pack4(v[0]); } };
struct SkWinU { float* U;
    __device__ __forceinline__ void operator()(int sr, int nt, int c4, const f32x4* v) const { *(f32x4*)(U + (size_t)(NP + sr) * CWD + nt * 16 + c4) = v[0] * v[1]; } };
struct SkWinG { bf16_t* SGA; bf16_t* SGB;
    __device__ __forceinline__ void operator()(int sr, int nt, int c4, const f32x4* v) const { const int col = nt * 16 + c4; f32x4 o;
#pragma unroll
        for (int j = 0; j < 4; ++j) o[j] = sigm_f(v[0][j]);
        if (col < D) *(u32x2*)(SGA + (size_t)(NP + sr) * D + col) = pack4(o); else *(u32x2*)(SGB + (size_t)(NP + sr) * D + col - D) = pack4(o); } };
struct SkGrp { bf16_t* AP; const float* scale; int g;
    __device__ __forceinline__ void operator()(int sr, int nt, int c4, const f32x4* v) const { const int col = g * 256 + nt * 16 + c4;
        *(u32x2*)(AP + (size_t)(NP + sr) * PW + col) = pack4(v[0] * *(const f32x4*)(scale + col)); } };
template <int MODE> struct SkBr { const bf16_t* SG; bf16_t* TA; bf16_t* MO;
    __device__ __forceinline__ void operator()(int sr, int nt, int c4, const f32x4* v) const { const size_t o = (size_t)(NP + sr) * D + nt * 16 + c4;
        f32x4 r = unpack4(*(const u32x2*)(SG + o)) * v[0];
        if (MODE == 1) { r += unpack4(*(const u32x2*)(TA + o)); *(u32x2*)(MO + o) = pack4(r); } else *(u32x2*)(TA + o) = pack4(r); } };

#define XB_TMO      128
#define XB_XCNT(j)  (256  + 64 * (j))
#define XB_XSUB(j)  (1280 + 64 * (j))
#define XB_XGEN(j)  (2304 + 64 * (j))
#define XB_TOP      3328
#define XB_TOPGEN   3392
#define XCD_BAR_WORDS 3456
#define XB_SPIN_CAP (1u << 20)
__device__ __forceinline__ unsigned xb_ld(unsigned* p)              { return __hip_atomic_load(p, __ATOMIC_RELAXED, __HIP_MEMORY_SCOPE_AGENT); }
__device__ __forceinline__ unsigned xb_add(unsigned* p, unsigned v) { return __hip_atomic_fetch_add(p, v, __ATOMIC_RELAXED, __HIP_MEMORY_SCOPE_AGENT); }
__device__ __forceinline__ unsigned xb_xcc_id() { return (unsigned)__builtin_amdgcn_s_getreg((3 << 11) | 20) & 0xFu; }
#define XB_SPIN(cond, bar) do { unsigned _sp = 0; while (cond) { __builtin_amdgcn_s_sleep(1); \
    if ((++_sp & 255u) == 0u) { if (xb_ld(&(bar)[XB_TMO])) break; if (_sp > XB_SPIN_CAP) { atomicAdd(&(bar)[XB_TMO], 1u); break; } } } } while (0)
__device__ __forceinline__ void xcd_barrier_complete(unsigned* bar, unsigned x, unsigned G, unsigned& nloc, unsigned& nx) {
    unsigned sum, cnt, mine, sp = 0u;
    for (;;) {
        sum = 0u; cnt = 0u; mine = 0u;
#pragma unroll
        for (unsigned j = 0; j < 16; ++j) { const unsigned c = xb_ld(&bar[XB_XCNT(j)]); sum += c; cnt += (c > 0u) ? 1u : 0u; mine = (j == x) ? c : mine; }
        if (sum == G) break;
        __builtin_amdgcn_s_sleep(1);
        if ((++sp & 255u) == 0u) { if (xb_ld(&bar[XB_TMO])) break; if (sp > XB_SPIN_CAP) { atomicAdd(&bar[XB_TMO], 1u); break; } }
    }
    nloc = mine > 0u ? mine : 1u; nx = cnt > 0u ? cnt : 1u;
}
__device__ __forceinline__ void grid_barrier(unsigned* bar, volatile LAS unsigned* st, unsigned G, int wid) {
    asm volatile("s_waitcnt vmcnt(0) lgkmcnt(0)" ::: "memory");
    __builtin_amdgcn_s_barrier();
    if (wid == 0 && lane_id_v() == 0) {
        const unsigned x = xb_xcc_id();
        unsigned nloc = st[0], nx = st[1];
        if (nloc == 0u) { xcd_barrier_complete(bar, x, G, nloc, nx); st[0] = nloc; st[1] = nx; }
        const unsigned old = xb_add(&bar[XB_XSUB(x)], 1u);
        const unsigned gen = old / nloc;
        if (old + 1u == (gen + 1u) * nloc) {
            __builtin_amdgcn_fence(__ATOMIC_RELEASE, "agent");
            asm volatile("s_waitcnt vmcnt(0)" ::: "memory");
            const unsigned og = xb_add(&bar[XB_TOP], 1u);
            const unsigned tg = og / nx;
            if (og + 1u == (tg + 1u) * nx) xb_add(&bar[XB_TOPGEN], 1u);
            else XB_SPIN(xb_ld(&bar[XB_TOPGEN]) == tg, bar);
            __builtin_amdgcn_fence(__ATOMIC_ACQUIRE, "agent");
            xb_add(&bar[XB_XGEN(x)], 1u);
            asm volatile("s_waitcnt vmcnt(0)" ::: "memory");
        } else {
            XB_SPIN(xb_ld(&bar[XB_XGEN(x)]) == gen, bar);
            __builtin_amdgcn_fence(__ATOMIC_ACQUIRE, "agent");
            asm volatile("s_waitcnt vmcnt(0)" ::: "memory");
        }
    }
    asm volatile("s_waitcnt vmcnt(0) lgkmcnt(0)" ::: "memory");
    __builtin_amdgcn_s_barrier();
    asm volatile("" ::: "memory");
}

constexpr int N_PHASES = 16;
__global__ void __launch_bounds__(NTHREADS, 2) fwd_kernel(Args a) {
    extern __shared__ __attribute__((aligned(16))) unsigned char lds_raw[];
    LAS unsigned char* lds = (LAS unsigned char*)lds_raw;
    const int G = gridDim.x, bx = blockIdx.x, wid = __builtin_amdgcn_readfirstlane(threadIdx.x >> 6);
    unsigned char* ws = a.ws;
    float* mod = (float*)(ws + WS_MOD); bf16_t* H = (bf16_t*)(ws + WS_H); float* XR = (float*)(ws + WS_XR); bf16_t* ACT = (bf16_t*)(ws + WS_R1);
#if ONE_LAUNCH
    if (wid == 0) { const int l0 = lane_id_v(); if (l0 < 2) ((volatile LAS unsigned*)(lds + 131072))[l0] = 0u; if (l0 == 0) (void)xb_add((unsigned*)(ws + WS_CTL) + XB_XCNT(xb_xcc_id()), 1u); }
    cg::this_grid().sync();
#define SEAM(k) do { STAMP(2 * (k)); if ((k) + 1 < a.ph_hi) grid_barrier((unsigned*)(ws + WS_CTL), (volatile LAS unsigned*)(lds + 131072), (unsigned)G, wid); STAMP(2 * (k) + 1); } while (0)
#else
#define SEAM(k) do { } while (0)
#endif
#define IN(k) (a.ph_lo <= (k) && (k) < a.ph_hi)
#ifdef TS_A
#define STAMP(j) do { if (bx == 0 && wid == 0) { asm volatile("s_waitcnt vmcnt(0)" ::: "memory"); ((volatile unsigned long long*)(ws + WS_TS))[(j)] = __builtin_amdgcn_s_memrealtime(); } } while (0)
#else
#define STAMP(j) do { } while (0)
#endif
#ifdef DBG_STOP
#define DBG_DUMP(k, expr) do { if ((k) == DBG_STOP) { const size_t n_out = (size_t)MR * D + (size_t)NB * 17 * PW + (size_t)NS * 17 * PW; \
        for (size_t i = (size_t)bx * NTHREADS + wid * 64 + lane_id_v(); i < n_out; i += (size_t)G * NTHREADS) a.out[i] = (expr); return; } } while (0)
#else
#define DBG_DUMP(k, expr) do { } while (0)
#endif
    pg8::StaticOrder S;
    STAMP(40);
    if (IN(0)) { p0a_prologue(a, lds, G, wid); SEAM(0); }
    if (IN(1)) { pg8::Gemm g{(const bf16_t*)(ws + WS_CS), (const bf16_t*)(ws + WS_R1), D, D, 0}; S.init(1, NMOD / 256, G, bx); EpiMod E{mod, a.in[7]}; pg8::gemm_phase(lds, g, S, E, wid);
        __syncthreads(); p0b_prologue(a, lds, G, wid, (NMOD / 256 < G / 2) ? NMOD / 256 : 0); SEAM(1); }
    if (IN(2)) { rowmod_phase(a.in[0], a.in[1], a.in[8], mod, 0, H, G, wid); SEAM(2); }
    const int PT = NP / 256;
    const bf16_t* Hs = H + (size_t)NP * D; const bf16_t* ACTs = ACT + (size_t)NP * FF; float* XRs = XR + (size_t)NP * D;
    const int PLAIN = 30;
    if (IN(3)) { pg8::Gemm g{H, (const bf16_t*)(ws + WS_WGU1), D, D, 0}; S.init(PT, 2 * FF / 256, G, bx, 2 * FF / 256, PT); EpiGU E{ACT}; pg8::gemm_phase(lds, g, S, E, wid);
        { const int nu = (PT + 1) * (2 * FF / 256), lo = nu % G; if (lo > 0 && lo < G) { __syncthreads(); late_cvt(a, lds, G, wid, lo, 0); } } SEAM(3); }
    if (IN(4)) { pg8::Gemm g{ACT, (const bf16_t*)(ws + WS_WD1), FF, FF, 0}; S.init(PT, D / 256, G, bx); EpiRes E{a.in[0], a.in[1], XR, mod + 2 * D, 0.5f}; pg8::gemm_phase(lds, g, S, E, wid);
        SkRes SE{a.in[1], XR, mod + 2 * D, 0.5f}; skinny_phase<1>(lds, ACTs, FF, (const bf16_t*)(ws + WS_WD1), FF, D / 16, PLAIN, 0, 0, SE, bx, 0, G, wid); SEAM(4); }
    if (IN(5)) { rowmod_phase(XR, XR + (size_t)NP * D, a.in[12], mod, 3, H, G, wid); SEAM(5); }
    if (IN(6)) { pg8::Gemm g{H, (const bf16_t*)(ws + WS_WIN), D, D, 0}; S.init(PT, INC / 256, G, bx);
        EpiWin E{(float*)(ws + WS_P), (bf16_t*)(ws + WS_CB), (float*)(ws + WS_U), (bf16_t*)(ws + WS_SGA), (bf16_t*)(ws + WS_SGB)}; pg8::gemm_phase(lds, g, S, E, wid);
        const bf16_t* Win = (const bf16_t*)(ws + WS_WIN);
        SkWinA SA{(float*)(ws + WS_P), (bf16_t*)(ws + WS_CB)}; skinny_phase<1>(lds, Hs, D, Win, D, 2048 / 16, PLAIN, 0, 0, SA, bx, 0, G, wid);
        SkWinU SU{(float*)(ws + WS_U)}; skinny_phase<2>(lds, Hs, D, Win + (size_t)2048 * D, D, 1024 / 16, 3, 8, 128, SU, bx, G / 2, G - G / 2, wid);
        SkWinG SG{(bf16_t*)(ws + WS_SGA), (bf16_t*)(ws + WS_SGB)}; skinny_phase<1>(lds, Hs, D, Win + (size_t)4096 * D, D, 4096 / 16, PLAIN, 0, 0, SG, bx, 0, G, wid); SEAM(6); }
    if (IN(7)) { mixer_phase(a, G, wid); SEAM(7); }
    if (IN(8)) { pg8::Gemm g{(const bf16_t*)(ws + WS_AIN), (const bf16_t*)(ws + WS_WGRP), PW, 256, 256}; S.init(PT, PW / 256, G, bx); EpiGrp E{(bf16_t*)(ws + WS_AP), a.in[15], 0}; pg8::gemm_phase(lds, g, S, E, wid);
        for (int gi = 0; gi < 4; ++gi) { SkGrp SE{(bf16_t*)(ws + WS_AP), a.in[15], gi};
            skinny_phase<1>(lds, (const bf16_t*)(ws + WS_AIN) + (size_t)NP * PW + gi * 256, PW, (const bf16_t*)(ws + WS_WGRP) + (size_t)gi * 65536, 256, 16, PLAIN, 0, 0, SE, bx, G / 2 + gi * (G / 8), G / 8, wid); }
        SEAM(8); }
    if (IN(9)) { pg8::Gemm g{(const bf16_t*)(ws + WS_AP), (const bf16_t*)(ws + WS_WA), PW, PW, 0}; S.init(PT, D / 256, G, bx); EpiBr<0> E{(const bf16_t*)(ws + WS_SGA), (bf16_t*)(ws + WS_TA), nullptr}; pg8::gemm_phase(lds, g, S, E, wid);
        SkBr<0> SE{(const bf16_t*)(ws + WS_SGA), (bf16_t*)(ws + WS_TA), nullptr}; skinny_phase<1>(lds, (const bf16_t*)(ws + WS_AP) + (size_t)NP * PW, PW, (const bf16_t*)(ws + WS_WA), PW, D / 16, PLAIN, 0, 0, SE, bx, 0, G, wid); }
    if (IN(10)) { pg8::Gemm g{(const bf16_t*)(ws + WS_V), (const bf16_t*)(ws + WS_WB), CWD, CWD, 0}; S.init(PT, D / 256, G, bx); EpiBr<1> E{(const bf16_t*)(ws + WS_SGB), (bf16_t*)(ws + WS_TA), H}; pg8::gemm_phase(lds, g, S, E, wid);
        SkBr<1> SE{(const bf16_t*)(ws + WS_SGB), (bf16_t*)(ws + WS_TA), H}; skinny_phase<1>(lds, (const bf16_t*)(ws + WS_V) + (size_t)NP * CWD, CWD, (const bf16_t*)(ws + WS_WB), CWD, D / 16, PLAIN, 0, 0, SE, bx, 0, G, wid); SEAM(10); }
    if (IN(11)) { pg8::Gemm g{H, (const bf16_t*)(ws + WS_WO), D, D, 0}; S.init(PT, D / 256, G, bx); EpiRes E{XR, XRs, XR, mod + 5 * D, 1.0f}; pg8::gemm_phase(lds, g, S, E, wid);
        SkRes SE{XRs, XR, mod + 5 * D, 1.0f}; skinny_phase<1>(lds, Hs, D, (const bf16_t*)(ws + WS_WO), D, D / 16, PLAIN, 0, 0, SE, bx, 0, G, wid); SEAM(11); }
    if (IN(12)) { rowmod_phase(XR, XR + (size_t)NP * D, a.in[21], mod, 6, H, G, wid); SEAM(12); }
    if (IN(13)) { pg8::Gemm g{H, (const bf16_t*)(ws + WS_WGU2), D, D, 0}; S.init(PT, 2 * FF / 256, G, bx, 2 * FF / 256, PT); EpiGU E{ACT}; pg8::gemm_phase(lds, g, S, E, wid);
        { const int nu = (PT + 1) * (2 * FF / 256), lo = nu % G; if (lo > 0 && lo < G) { __syncthreads(); late_cvt(a, lds, G, wid, lo, 1); } } SEAM(13); }
    if (IN(14)) { pg8::Gemm g{ACT, (const bf16_t*)(ws + WS_WD2), FF, FF, 0}; S.init(PT, D / 256, G, bx); EpiRes E{XR, XRs, XR, mod + 8 * D, 0.5f}; pg8::gemm_phase(lds, g, S, E, wid);
        SkRes SE{XRs, XR, mod + 8 * D, 0.5f}; skinny_phase<1>(lds, ACTs, FF, (const bf16_t*)(ws + WS_WD2), FF, D / 16, PLAIN, 0, 0, SE, bx, 0, G, wid); SEAM(14); }
    if (IN(15)) { final_norm_phase(XR, a.in[25], a.out, G, wid); }
#ifdef TS_A
    if (bx == 0 && wid == 0) { asm volatile("s_waitcnt vmcnt(0)" ::: "memory"); volatile unsigned long long* ts = (volatile unsigned long long*)(ws + WS_TS);
        const unsigned long long d = (ts[TS_B] - ts[TS_A]) * TS_F, t0 = __builtin_amdgcn_s_memrealtime();
        while (__builtin_amdgcn_s_memrealtime() - t0 < d) __builtin_amdgcn_s_sleep(8); }
#endif
#undef IN
#undef SEAM
}

extern "C" void kernel_launch(void* const* d_in, const int* in_sizes, int n_in, void* d_out, int out_size, void* d_ws, size_t ws_size, hipStream_t stream) {
    static int grid = 0;
    if (grid == 0) {
        if (n_in != 26 || ws_size < WS_END) { fprintf(stderr, "kernel_launch: unexpected n_in %d / ws %zu (need %zu)\n", n_in, ws_size, (size_t)WS_END); grid = -1; return; }
        int dev = 0, cus = 0, per_cu = 0;
        (void)hipGetDevice(&dev); (void)hipDeviceGetAttribute(&cus, hipDeviceAttributeMultiprocessorCount, dev);
        if (hipFuncSetAttribute((const void*)fwd_kernel, hipFuncAttributeMaxDynamicSharedMemorySize, LDS_BYTES) != hipSuccess) { fprintf(stderr, "kernel_launch: hipFuncSetAttribute failed\n"); grid = -1; return; }
        if (hipOccupancyMaxActiveBlocksPerMultiprocessor(&per_cu, (const void*)fwd_kernel, NTHREADS, LDS_BYTES) != hipSuccess || per_cu < 1) { fprintf(stderr, "kernel_launch: occupancy query gives %d\n", per_cu); per_cu = 1; }
        (void)hipGetLastError();
        grid = cus * 1;
    }
    if (grid < 0) return;
    Args a{};
    for (int i = 0; i < 26; ++i) a.in[i] = (const float*)d_in[i];
    a.out = (float*)d_out; a.ws = (unsigned char*)d_ws;
#if ONE_LAUNCH
    a.ph_lo = 0; a.ph_hi = N_PHASES;
    (void)hipMemsetAsync((unsigned char*)d_ws + WS_CTL, 0, 16384, stream);
    void* args[] = {&a};
    hipError_t e = hipLaunchCooperativeKernel((const void*)fwd_kernel, dim3(grid), dim3(NTHREADS), args, LDS_BYTES, stream);
    if (e != hipSuccess) fprintf(stderr, "cooperative launch failed: %s (grid %d)\n", hipGetErrorString(e), grid);
#else
    for (int ph = 0; ph < N_PHASES; ++ph) { a.ph_lo = ph; a.ph_hi = ph + 1; hipLaunchKernelGGL(fwd_kernel, dim3(grid), dim3(NTHREADS), LDS_BYTES, stream, a); }
#endif
}
```
